# Optimizing an MI355X kernel written in HIP

```python
import jax, jax.numpy as jnp
from jax import lax
import numpy as np

D_MODEL = 1024
BATCH = 16
SEQ = 2048
DEPTH = 1

MEM_LEN = 256
HEAD_DIM = 64
CHUNK = 128
A_GROUPS = 4
A_WIDTH = D_MODEL // 2
A_GROUP_W = A_WIDTH // A_GROUPS
SWA_HEADS = 4
SWA_KV_HEADS = 2
SWA_WIDTH = SWA_HEADS * HEAD_DIM
SWA_KV_WIDTH = SWA_KV_HEADS * HEAD_DIM
WINDOW = 128
MEM_HEADS = 4
MEM_WIDTH = MEM_HEADS * HEAD_DIM
MIX_WIDTH = A_WIDTH + SWA_WIDTH + MEM_WIDTH
IN_WIDTH = 2 * A_WIDTH + SWA_WIDTH + 2 * SWA_KV_WIDTH + MEM_WIDTH + MIX_WIDTH
N_BUCKETS = 32
MAX_DISTANCE = 128
EPS = 1e-6
NEG = -1e30

kernel_name = "hymba_gmlp_swa_sink_memxattn_layer"


def rms_norm(x, g):
    xf = x.astype(jnp.float32)
    y = xf * lax.rsqrt(jnp.mean(xf * xf, axis=-1, keepdims=True) + EPS)
    return (y * g.astype(jnp.float32)).astype(x.dtype)


def t5_causal_buckets(dist):
    n = np.maximum(dist, 0)
    max_exact = N_BUCKETS // 2
    large = max_exact + (np.log(np.maximum(n, 1) / max_exact) / np.log(MAX_DISTANCE / max_exact)
                         * (N_BUCKETS - max_exact)).astype(np.int32)
    large = np.minimum(large, N_BUCKETS - 1)
    return np.where(n < max_exact, n, large).astype(np.int32)


def chunked_spatial_gating(u, v, v_g, v_b, w_s, b_s):
    b, s, _ = u.shape
    nc = s // CHUNK
    vg = v.reshape(b, s, A_GROUPS, A_GROUP_W).astype(jnp.float32)
    mu = jnp.mean(vg, axis=-1, keepdims=True)
    var = jnp.mean(jnp.square(vg - mu), axis=-1, keepdims=True)
    vg = (vg - mu) * lax.rsqrt(var + EPS)
    vg = vg * v_g.reshape(A_GROUPS, A_GROUP_W).astype(jnp.float32) + v_b.reshape(A_GROUPS, A_GROUP_W).astype(jnp.float32)
    vc = vg.astype(v.dtype).reshape(b, nc, CHUNK, A_GROUPS, A_GROUP_W)
    causal = jnp.tril(jnp.ones((CHUNK, CHUNK), dtype=w_s.dtype))
    w = w_s * causal[None]
    sv = jnp.einsum('gts,bnsgc->bntgc', w, vc) + b_s.T[None, None, :, :, None]
    return u * sv.reshape(b, s, A_WIDTH)


def sliding_window_attention(q, k, v, sinks, rel_bias):
    b, s, hq, dh = q.shape
    nb = s // CHUNK
    g = hq // SWA_KV_HEADS
    qb = q.reshape(b, nb, CHUNK, SWA_KV_HEADS, g, dh)

    def band(t):
        tb = t.reshape(b, nb, CHUNK, SWA_KV_HEADS, dh)
        prev = jnp.pad(tb, ((0, 0), (1, 0), (0, 0), (0, 0), (0, 0)))[:, :-1]
        return jnp.concatenate([prev, tb], axis=2)

    kb, vb = band(k), band(v)
    logits = jnp.einsum('bnqhgd,bnjhd->bnhgqj', qb, kb).astype(jnp.float32) * (dh ** -0.5)

    qi = np.arange(CHUNK)[:, None]
    kj = np.arange(2 * CHUNK)[None, :]
    dist = qi + CHUNK - kj
    blk = np.arange(nb)[:, None, None]
    valid = (dist >= 0) & (dist < WINDOW) & (blk * CHUNK + kj - CHUNK >= 0)
    buckets = t5_causal_buckets(dist)
    bias = rel_bias.astype(jnp.float32)[buckets]
    bias = jnp.transpose(bias, (2, 0, 1)).reshape(SWA_KV_HEADS, g, CHUNK, 2 * CHUNK)

    logits = jnp.where(valid[None, :, None, None], logits + bias[None, None], NEG)
    sink = sinks.astype(jnp.float32).reshape(1, 1, SWA_KV_HEADS, g, 1, 1)
    m = jnp.maximum(jnp.max(logits, axis=-1, keepdims=True), sink)
    p = jnp.exp(logits - m)
    probs = p / (jnp.sum(p, axis=-1, keepdims=True) + jnp.exp(sink - m))
    out = jnp.einsum('bnhgqj,bnjhd->bnqhgd', probs.astype(v.dtype), vb)
    return out.reshape(b, s, hq * dh)


def memory_cross_attention(q, mem_k, mem_v):
    b, s, h, dh = q.shape
    logits = jnp.einsum('bshd,bmhd->bhsm', q, mem_k).astype(jnp.float32) * (dh ** -0.5)
    probs = jax.nn.softmax(logits, axis=-1)
    out = jnp.einsum('bhsm,bmhd->bshd', probs.astype(mem_v.dtype), mem_v)
    return out.reshape(b, s, h * dh)


def setup_inputs(seed: int = 0) -> dict:
    key = jax.random.key(seed)
    ks = jax.random.split(key, 16)
    f32 = jnp.float32
    x = jax.random.normal(ks[0], (BATCH, SEQ, D_MODEL), f32)
    mem = jax.random.normal(ks[1], (BATCH, MEM_LEN, D_MODEL), f32)
    pre_norm_g = 1.0 + 0.05 * jax.random.normal(ks[2], (DEPTH, D_MODEL), f32)
    post_norm_g = 1.0 + 0.05 * jax.random.normal(ks[3], (DEPTH, D_MODEL), f32)
    mem_norm_g = 1.0 + 0.05 * jax.random.normal(ks[4], (DEPTH, D_MODEL), f32)
    w_in = jax.random.normal(ks[5], (DEPTH, D_MODEL, IN_WIDTH), f32) * D_MODEL ** -0.5
    w_mem_kv = jax.random.normal(ks[6], (DEPTH, D_MODEL, 2 * MEM_WIDTH), f32) * D_MODEL ** -0.5
    v_norm_g = 1.0 + 0.05 * jax.random.normal(ks[7], (DEPTH, A_WIDTH), f32)
    v_norm_b = 0.02 * jax.random.normal(ks[8], (DEPTH, A_WIDTH), f32)
    w_spatial = jax.random.normal(ks[9], (DEPTH, A_GROUPS, CHUNK, CHUNK), f32) * CHUNK ** -0.5
    b_spatial = 1.0 + 0.1 * jax.random.normal(ks[10], (DEPTH, A_GROUPS, CHUNK), f32)
    attn_sinks = 0.5 * jax.random.normal(ks[11], (DEPTH, SWA_HEADS), f32)
    rel_bias = 0.5 * jax.random.normal(ks[12], (N_BUCKETS, SWA_HEADS), f32)
    w_out = jax.random.normal(ks[13], (DEPTH, MIX_WIDTH, D_MODEL), f32) * MIX_WIDTH ** -0.5
    return {"x": x, "mem": mem, "pre_norm_g": pre_norm_g, "post_norm_g": post_norm_g,
            "mem_norm_g": mem_norm_g, "w_in": w_in, "w_mem_kv": w_mem_kv,
            "v_norm_g": v_norm_g, "v_norm_b": v_norm_b, "w_spatial": w_spatial,
            "b_spatial": b_spatial, "attn_sinks": attn_sinks, "rel_bias": rel_bias,
            "w_out": w_out}


def reference(x, mem, pre_norm_g, post_norm_g, mem_norm_g, w_in, w_mem_kv, v_norm_g, v_norm_b,
              w_spatial, b_spatial, attn_sinks, rel_bias, w_out):
    b, s, _ = x.shape
    m_len = mem.shape[1]
    split_at = np.cumsum([A_WIDTH, A_WIDTH, SWA_WIDTH, SWA_KV_WIDTH, SWA_KV_WIDTH, MEM_WIDTH]).tolist()
    for layer in range(DEPTH):
        h = rms_norm(x, pre_norm_g[layer])
        proj = h @ w_in[layer]
        a_u, a_v, sq, sk, sv, mq, z = jnp.split(proj, split_at, axis=-1)

        y_a = chunked_spatial_gating(jax.nn.gelu(a_u), jax.nn.gelu(a_v), v_norm_g[layer],
                                     v_norm_b[layer], w_spatial[layer], b_spatial[layer])

        y_b = sliding_window_attention(sq.reshape(b, s, SWA_HEADS, HEAD_DIM),
                                       sk.reshape(b, s, SWA_KV_HEADS, HEAD_DIM),
                                       sv.reshape(b, s, SWA_KV_HEADS, HEAD_DIM),
                                       attn_sinks[layer], rel_bias)

        mkv = rms_norm(mem, mem_norm_g[layer]) @ w_mem_kv[layer]
        mk, mv = jnp.split(mkv, 2, axis=-1)
        y_c = memory_cross_attention(mq.reshape(b, s, MEM_HEADS, HEAD_DIM),
                                     mk.reshape(b, m_len, MEM_HEADS, HEAD_DIM),
                                     mv.reshape(b, m_len, MEM_HEADS, HEAD_DIM))

        y = jnp.concatenate([y_a, y_b, y_c], axis=-1) * jax.nn.silu(z)
        x = x + rms_norm(y @ w_out[layer], post_norm_g[layer])
    return x
```

```cpp
#include <hip/hip_runtime.h>
#include <cstdio>
#include <cstdint>

namespace pg8 {
#define PG8_LAS __attribute__((address_space(3)))
typedef unsigned short bf16_t;
typedef short bf16x8 __attribute__((ext_vector_type(8)));
typedef float f32x4 __attribute__((ext_vector_type(4)));
typedef unsigned u32x4 __attribute__((ext_vector_type(4)));
constexpr int BM = 256, BK = 64, HALF = 128, HTB = HALF * BK * 2, STAGE_BYTES = 8 * HTB, NXCD = 8, WGM = 8;

__host__ __device__ __forceinline__ int lds_byte(int r, int c) { const int st = (r >> 4) * 2 + (c >> 5), rr = r & 15, cc = c & 31, ob = rr * 64 + cc * 2; return st * 1024 + (ob ^ (((ob >> 9) & 1) << 5)); }
__host__ __device__ __forceinline__ void stage_rc(int b, int& R, int& C) { const int st = b / 1024, sb = b % 1024, swz = sb ^ (((sb >> 9) & 1) << 5); R = (st >> 1) * 16 + swz / 64; C = (st & 1) * 32 + (swz % 64) / 2; }
__host__ __device__ __forceinline__ int perm32(int rho) { const int n = rho >> 4, i = rho & 15; return 8 * (i >> 2) + 4 * n + (i & 3); }

struct Unit { int pm, pn; };
struct Gemm { const bf16_t* A; const bf16_t* Bt; int M, N, K; };

struct StaticOrder {
    int nM, nN, nwg, G, c, wgm;
    __host__ __device__ void init(int M, int N, int G_, int c_, int wgm_ = WGM) { nM = M / BM; nN = N / BM; nwg = nM * nN; G = G_; c = c_; wgm = wgm_; }
    __host__ __device__ void map(int wgid, Unit& u) const {
        { const int q = nwg / NXCD, r = nwg % NXCD, xcd = wgid % NXCD, off = wgid / NXCD; wgid = (xcd < r ? xcd * (q + 1) : r * (q + 1) + (xcd - r) * q) + off; }
        const int nig = wgm * nN, gid = wgid / nig, fm = gid * wgm, gsz = (nM - fm) < wgm ? (nM - fm) : wgm;
        u.pm = fm + ((wgid % nig) % gsz); u.pn = (wgid % nig) / gsz;
    }
    __host__ __device__ bool next(int i, Unit& u) const { const long L = (long)i * G + c; if (L >= nwg) return false; map((int)L, u); return true; }
    __device__ __forceinline__ void a_ready(const Unit&) const {}
    __device__ __forceinline__ void done(const Unit&) const {}
};
struct MergedOrder {
    StaticOrder S; int eM, eN, ePm0;
    __host__ __device__ bool next(int i, Unit& u) const {
        const int G = S.G, c = S.c, nfull = S.nwg / G, rem = S.nwg - nfull * G, nx = eM * eN;
        if (nfull < 1 || rem + 2 * nx > G) {
            if (S.next(i, u)) return true;
            const long L = (long)i * G + c - S.nwg; if (L >= (long)nx) return false;
            u.pm = ePm0 + (int)(L / eN); u.pn = S.nN + (int)(L % eN); return true;
        }
        if (c >= rem && c < rem + nx) {
            if (i < nfull - 1) return S.next(i, u);
            if (i > nfull - 1) return false;
            const int e = c - rem; u.pm = ePm0 + e / eN; u.pn = S.nN + e % eN; return true;
        }
        if (c >= rem + nx && c < rem + 2 * nx) {
            if (i < nfull) return S.next(i, u);
            if (i > nfull) return false;
            S.map((nfull - 1) * G + (c - nx), u); return true;
        }
        return S.next(i, u);
    }
    __device__ __forceinline__ void a_ready(const Unit&) const {}
    __device__ __forceinline__ void done(const Unit&) const {}
};

__device__ __forceinline__ unsigned cvt_pk_bf16(float lo, float hi) { unsigned r; asm volatile("v_cvt_pk_bf16_f32 %0, %1, %2" : "=v"(r) : "v"(lo), "v"(hi)); return r; }

template <class Epi, class Sched, bool ALIGN_EPI = false, bool SP2 = false>
__device__ __forceinline__ void gemm_phase(PG8_LAS unsigned char* lds, const Gemm g, const Sched& S, const Epi& E) {
    const int tid = threadIdx.x, wid = __builtin_amdgcn_readfirstlane(tid >> 6), lane = tid & 63, wr = wid >> 2, wc = wid & 3, fr = lane & 15, fq = lane >> 4;
    const int K = g.K, nt = K / BK;
    unsigned voffA[2], voffB[2];
#pragma unroll
    for (int i = 0; i < 2; ++i) { int R, C; stage_rc(tid * 16 + i * 8192, R, C); const int Rb = Epi::PERM ? ((R & ~31) + perm32(R & 31)) : R;
        voffA[i] = (unsigned)(R * K + C) * 2u; voffB[i] = (unsigned)(Rb * K + C) * 2u; }
    const size_t kstep = (size_t)(BK * 2);
    const size_t hstep = (size_t)HALF * K * 2;
    const size_t tstep = 2 * hstep;
    const unsigned ldsw = (unsigned)wid * 1024u;
    const int aoff = lds_byte(wr * 64 + fr, fq * 8), boff = lds_byte(wc * 32 + fr, fq * 8);
#define PG8_SA(b, h) (((b) * 2 + (h)) * HTB)
#define PG8_SB(b, h) ((4 + (b) * 2 + (h)) * HTB)
#define PG8_STAGE(bufoff, gbase, voff) do { _Pragma("unroll") for (int _i = 0; _i < 2; ++_i) \
        __builtin_amdgcn_global_load_lds((const unsigned*)((const char*)(gbase) + (voff)[_i]), (PG8_LAS unsigned*)(lds + (bufoff) + ldsw + _i * 8192), 16, 0, 0); } while (0)
#define PG8_LDA(dst, b, h) do { _Pragma("unroll") for (int m = 0; m < 4; ++m) _Pragma("unroll") for (int k = 0; k < 2; ++k) dst[m][k] = *(const PG8_LAS bf16x8*)(lds + PG8_SA(b, h) + aoff + m * 2048 + k * 1024); } while (0)
#define PG8_LDB(dst, b, h) do { _Pragma("unroll") for (int n = 0; n < 2; ++n) _Pragma("unroll") for (int k = 0; k < 2; ++k) dst[n][k] = *(const PG8_LAS bf16x8*)(lds + PG8_SB(b, h) + boff + n * 2048 + k * 1024); } while (0)
#define PG8_MMA(ai, bj, At, Bt) do { __builtin_amdgcn_s_setprio(1); _Pragma("unroll") for (int m = 0; m < 4; ++m) _Pragma("unroll") for (int n = 0; n < 2; ++n) _Pragma("unroll") for (int k = 0; k < 2; ++k) \
        acc[ai][bj][m][n] = __builtin_amdgcn_mfma_f32_16x16x32_bf16(Bt[n][k], At[m][k], acc[ai][bj][m][n], 0, 0, 0); __builtin_amdgcn_s_setprio(0); } while (0)
#define PG8_WAIT_V(n) asm volatile("s_waitcnt vmcnt(" #n ")" ::: "memory")
#define PG8_WAIT_L(n) asm volatile("s_waitcnt lgkmcnt(" #n ")" ::: "memory")
#define PG8_BAR __builtin_amdgcn_s_barrier()
#define PG8_SCHED __builtin_amdgcn_sched_barrier(0)
    Unit cur, nxt; int ui = 0;
    if (!S.next(0, cur)) return;
    f32x4 acc[2][2][4][2];
#pragma unroll
    for (int a = 0; a < 2; ++a)
#pragma unroll
        for (int b = 0; b < 2; ++b)
#pragma unroll
            for (int m = 0; m < 4; ++m)
#pragma unroll
                for (int n = 0; n < 2; ++n) acc[a][b][m][n] = (f32x4){0.f, 0.f, 0.f, 0.f};
    bf16x8 At[4][2], B0[2][2], B1[2][2];
    const char* cA = (const char*)g.A + (size_t)cur.pm * tstep; const char* cB = (const char*)g.Bt + (size_t)cur.pn * tstep;
    S.a_ready(cur);
    if constexpr (SP2) {
        PG8_STAGE(PG8_SB(0, 0), cB, voffB); PG8_STAGE(PG8_SB(0, 1), cB + hstep, voffB); PG8_STAGE(PG8_SA(0, 0), cA, voffA); PG8_STAGE(PG8_SA(0, 1), cA + hstep, voffA);
        if (wr == 1) PG8_BAR;
        PG8_WAIT_V(2); PG8_BAR;
        PG8_STAGE(PG8_SB(1, 0), cB + kstep, voffB); PG8_STAGE(PG8_SA(1, 0), cA + kstep, voffA); PG8_STAGE(PG8_SB(1, 1), cB + hstep + kstep, voffB);
        PG8_WAIT_V(6); PG8_BAR;
    } else {
        PG8_STAGE(PG8_SB(0, 0), cB, voffB); PG8_STAGE(PG8_SA(0, 0), cA, voffA); PG8_STAGE(PG8_SB(0, 1), cB + hstep, voffB); PG8_STAGE(PG8_SA(0, 1), cA + hstep, voffA);
        if (wr == 1) PG8_BAR;
        PG8_WAIT_V(4); PG8_BAR;
        PG8_STAGE(PG8_SB(1, 0), cB + kstep, voffB); PG8_STAGE(PG8_SA(1, 0), cA + kstep, voffA); PG8_STAGE(PG8_SB(1, 1), cB + hstep + kstep, voffB);
        PG8_WAIT_V(6); PG8_BAR;
    }
    for (;;) {
        const bool has_next = S.next(ui + 1, nxt);
        const char* nA = has_next ? (const char*)g.A + (size_t)nxt.pm * tstep : cA; const char* nB = has_next ? (const char*)g.Bt + (size_t)nxt.pn * tstep : cB;
        for (int t = 0; t < nt; t += 2) {
            const bool last = (t == nt - 2);
            const char* a1 = cA + (size_t)(t + 1) * kstep;
            const char* a2 = last ? nA : cA + (size_t)(t + 2) * kstep; const char* b2 = last ? nB : cB + (size_t)(t + 2) * kstep;
            const char* a3 = a2 + kstep; const char* b3 = b2 + kstep;
            if (last && has_next) S.a_ready(nxt);
            if constexpr (SP2) {
            PG8_LDB(B0, 0, 0); PG8_LDB(B1, 0, 1); PG8_SCHED; PG8_LDA(At, 0, 0); PG8_STAGE(PG8_SA(1, 1), a1 + hstep, voffA);
            PG8_WAIT_V(8); PG8_WAIT_L(0); PG8_BAR; PG8_MMA(0, 0, At, B0); PG8_MMA(0, 1, At, B1); PG8_BAR; PG8_SCHED;
            PG8_LDA(At, 0, 1); PG8_STAGE(PG8_SB(0, 0), b2, voffB); PG8_STAGE(PG8_SB(0, 1), b2 + hstep, voffB); PG8_STAGE(PG8_SA(0, 0), a2, voffA);
            PG8_WAIT_V(8); PG8_WAIT_L(0); PG8_BAR; PG8_MMA(1, 0, At, B0); PG8_MMA(1, 1, At, B1); PG8_BAR; PG8_SCHED;
            PG8_LDB(B0, 1, 0); PG8_LDB(B1, 1, 1); PG8_SCHED; PG8_LDA(At, 1, 0); PG8_STAGE(PG8_SA(0, 1), a2 + hstep, voffA);
            PG8_WAIT_V(8); PG8_WAIT_L(0); PG8_BAR; PG8_MMA(0, 0, At, B0); PG8_MMA(0, 1, At, B1); PG8_BAR; PG8_SCHED;
            PG8_LDA(At, 1, 1); PG8_STAGE(PG8_SB(1, 0), b3, voffB); PG8_STAGE(PG8_SB(1, 1), b3 + hstep, voffB); PG8_STAGE(PG8_SA(1, 0), a3, voffA);
            PG8_WAIT_V(8); PG8_WAIT_L(0); PG8_BAR; PG8_MMA(1, 0, At, B0); PG8_MMA(1, 1, At, B1); PG8_BAR; PG8_SCHED;
            } else {
            PG8_LDB(B0, 0, 0); PG8_SCHED; PG8_LDA(At, 0, 0); PG8_STAGE(PG8_SA(1, 1), a1 + hstep, voffA);
            PG8_WAIT_L(8); PG8_BAR; PG8_WAIT_L(0); PG8_MMA(0, 0, At, B0); PG8_BAR; PG8_SCHED;
            PG8_LDB(B1, 0, 1); PG8_STAGE(PG8_SB(0, 0), b2, voffB);
            PG8_BAR; PG8_WAIT_L(0); PG8_MMA(0, 1, At, B1); PG8_BAR;
            PG8_LDA(At, 0, 1); PG8_STAGE(PG8_SA(0, 0), a2, voffA);
            PG8_BAR; PG8_WAIT_L(0); PG8_MMA(1, 0, At, B0); PG8_BAR; PG8_SCHED;
            PG8_STAGE(PG8_SB(0, 1), b2 + hstep, voffB);
            PG8_WAIT_V(6); PG8_BAR; PG8_MMA(1, 1, At, B1); PG8_BAR;
            PG8_LDB(B0, 1, 0); PG8_SCHED; PG8_LDA(At, 1, 0); PG8_STAGE(PG8_SA(0, 1), a2 + hstep, voffA);
            PG8_WAIT_L(8); PG8_BAR; PG8_WAIT_L(0); PG8_MMA(0, 0, At, B0); PG8_BAR; PG8_SCHED;
            PG8_LDB(B1, 1, 1); PG8_STAGE(PG8_SB(1, 0), b3, voffB);
            PG8_BAR; PG8_WAIT_L(0); PG8_MMA(0, 1, At, B1); PG8_BAR;
            PG8_LDA(At, 1, 1); PG8_STAGE(PG8_SA(1, 0), a3, voffA);
            PG8_BAR; PG8_WAIT_L(0); PG8_MMA(1, 0, At, B0); PG8_BAR; PG8_SCHED;
            PG8_STAGE(PG8_SB(1, 1), b3 + hstep, voffB);
            PG8_WAIT_V(6); PG8_BAR; PG8_MMA(1, 1, At, B1); PG8_BAR;
            }
        }
        if constexpr (ALIGN_EPI) { if (wr == 0) PG8_BAR; }
        E(acc, cur, wr, wc, fr, fq); S.done(cur);
        if (!has_next) break;
#pragma unroll
        for (int a = 0; a < 2; ++a)
#pragma unroll
            for (int b = 0; b < 2; ++b)
#pragma unroll
                for (int m = 0; m < 4; ++m)
#pragma unroll
                    for (int n = 0; n < 2; ++n) acc[a][b][m][n] = (f32x4){0.f, 0.f, 0.f, 0.f};
        cur = nxt; cA = nA; cB = nB; ++ui;
        if constexpr (ALIGN_EPI) { if (wr == 1) PG8_BAR; }
    }
    PG8_WAIT_V(0);
    if constexpr (!ALIGN_EPI) { if (wr == 0) PG8_BAR; }
    PG8_BAR;
#undef PG8_SA
#undef PG8_SB
#undef PG8_STAGE
#undef PG8_LDA
#undef PG8_LDB
#undef PG8_MMA
#undef PG8_WAIT_V
#undef PG8_WAIT_L
#undef PG8_BAR
#undef PG8_SCHED
}
}

typedef unsigned short bf16_t;
constexpr int D_MODEL = 1024, BATCH = 16, SEQ = 2048, MEM_LEN = 256, HD = 64, CHUNK = 128;
constexpr int M_TOK = BATCH * SEQ, M_MEM = BATCH * MEM_LEN;
constexpr int A_WIDTH = 512, IN_WIDTH = 2816, MKV_W = 512;
constexpr int C_U = 0, C_V = 512, C_SQ = 1024, C_SK = 1280, C_SV = 1408, C_MQ = 1536, C_Z = 1792;
constexpr size_t MT = (size_t)BATCH * SEQ;
constexpr size_t PU_OFF = 0, PV_OFF = PU_OFF + 4 * MT * 128, PQ_OFF = PV_OFF + 4 * MT * 128, PK_OFF = PQ_OFF + 4 * MT * 64, PVV_OFF = PK_OFF + 2 * MT * 64, PMQ_OFF = PVV_OFF + 2 * MT * 64, PZ_OFF = PMQ_OFF + 4 * MT * 64;
static_assert(PZ_OFF + 16 * MT * 64 == MT * 2816, "blocked PROJ layout covers exactly IN_WIDTH columns");
constexpr size_t MV_OFF = (size_t)BATCH * 4 * MEM_LEN * 64;
constexpr float EPS = 1e-6f;
constexpr float LOG2E = 1.4426950408889634f;
constexpr float QSCALE = 0.125f * LOG2E;
constexpr int NWAVES = 8;

constexpr size_t MiB = 1u << 20;
constexpr size_t WS_CTL = 0, CTL_ZERO_BYTES = 64 * 1024;
constexpr size_t WS_WIN = 2 * MiB;
constexpr size_t WS_WOUT = 10 * MiB;
constexpr size_t WS_WSP = 12 * MiB;
constexpr size_t WS_SSP = 13 * MiB;
constexpr size_t WS_XN = 16 * MiB;
constexpr size_t WS_PROJ = 96 * MiB;
constexpr size_t WS_MKV = 272 * MiB;
constexpr size_t WS_Y = 280 * MiB;
constexpr size_t WS_O = 344 * MiB;
constexpr size_t WS_END = 408 * MiB;
constexpr int CW_BAR = 1024;

constexpr int RING_BYTES = 131072, LDSCTL_OFF = 138240, MISC_OFF = LDSCTL_OFF + 320, LDS_BYTES = 147456;

#define GAS __attribute__((address_space(1)))
#define LAS __attribute__((address_space(3)))
typedef unsigned v4u __attribute__((ext_vector_type(4)));
typedef unsigned v2u __attribute__((ext_vector_type(2)));
typedef float f32x4 __attribute__((ext_vector_type(4)));
#define LDS_WAIT() asm volatile("s_waitcnt lgkmcnt(0)" ::: "memory")
#define VM_WAIT() asm volatile("s_waitcnt vmcnt(0)" ::: "memory")
__device__ __forceinline__ float bf2f(bf16_t v) { return __builtin_bit_cast(float, (unsigned)v << 16); }
__device__ __forceinline__ unsigned f2bf(float f) { unsigned u = __builtin_bit_cast(unsigned, f); return (u + 0x7fffu + ((u >> 16) & 1u)) >> 16; }
__device__ __forceinline__ unsigned pk2(float lo, float hi) { return f2bf(lo) | (f2bf(hi) << 16); }
__device__ __forceinline__ float bflo(unsigned w) { return __builtin_bit_cast(float, w << 16); }
__device__ __forceinline__ float bfhi(unsigned w) { return __builtin_bit_cast(float, w & 0xffff0000u); }
__device__ __forceinline__ float fast_sigmoid_mul(float x, float t) { return x * __builtin_amdgcn_rcpf(1.f + __builtin_amdgcn_exp2f(-t * LOG2E)); }
__device__ __forceinline__ float gelu_tanh(float x) { return fast_sigmoid_mul(x, 1.5957691216057308f * (x + 0.044715f * x * x * x)); }
__device__ __forceinline__ float silu(float x) { return fast_sigmoid_mul(x, x); }
typedef float f32x2 __attribute__((ext_vector_type(2)));
__device__ __forceinline__ f32x2 sigmoid_mul_pk(f32x2 x, f32x2 tneg) {
    f32x2 e; e.x = __builtin_amdgcn_exp2f(tneg.x); e.y = __builtin_amdgcn_exp2f(tneg.y);
    const f32x2 d = e + 1.0f; f32x2 r; r.x = __builtin_amdgcn_rcpf(d.x); r.y = __builtin_amdgcn_rcpf(d.y);
    return x * r;
}
__device__ __forceinline__ f32x2 gelu_tanh_pk(f32x2 x) { const f32x2 x2 = x * x; const f32x2 q = x2 * (-0.044715f * 1.5957691216057308f * LOG2E) + (-1.5957691216057308f * LOG2E); return sigmoid_mul_pk(x, x * q); }
__device__ __forceinline__ f32x2 silu_pk(f32x2 x) { return sigmoid_mul_pk(x, x * (-LOG2E)); }
__device__ __forceinline__ float wave_sum(float v) {
#pragma unroll
    for (int o = 1; o < 64; o <<= 1) v += __shfl_xor(v, o);
    return v;
}

#define XB_TMO      128
#define XB_XCNT(j)  (256  + 64 * (j))
#define XB_XSUB(j)  (1280 + 64 * (j))
#define XB_XGEN(j)  (2304 + 64 * (j))
#define XB_TOP      3328
#define XB_TOPGEN   3392
#define XCD_BAR_WORDS 3456
#define XB_SPIN_CAP (1u << 18)
__device__ __forceinline__ unsigned xb_ld(unsigned* p)              { return __hip_atomic_load(p, __ATOMIC_RELAXED, __HIP_MEMORY_SCOPE_AGENT); }
__device__ __forceinline__ unsigned xb_add(unsigned* p, unsigned v) { return __hip_atomic_fetch_add(p, v, __ATOMIC_RELAXED, __HIP_MEMORY_SCOPE_AGENT); }
__device__ __forceinline__ unsigned xb_xcc_id() { return (unsigned)__builtin_amdgcn_s_getreg((3 << 11) | 20) & 0xFu; }
#define XB_SPIN(cond, bar) do { unsigned _sp = 0; while (cond) { __builtin_amdgcn_s_sleep(1); \
    if ((++_sp & 255u) == 0u) { if (xb_ld(&(bar)[XB_TMO])) break; if (_sp > XB_SPIN_CAP) { atomicAdd(&(bar)[XB_TMO], 1u); break; } } } } while (0)
struct XcdBarrier { unsigned* bar; unsigned x; volatile LAS unsigned* st; unsigned n; };
__device__ __forceinline__ XcdBarrier xcd_barrier_post(unsigned* bar, volatile LAS unsigned* st, unsigned n) {
    XcdBarrier b; b.bar = bar; b.x = xb_xcc_id(); b.st = st; b.n = n;
    if (threadIdx.x == 0) (void)xb_add(&bar[XB_XCNT(b.x)], 1u);
    return b;
}
__device__ __forceinline__ void xcd_barrier_complete(unsigned* bar, unsigned x, unsigned G, unsigned& nloc, unsigned& nx) {
    unsigned sum, cnt, mine, sp = 0u;
    for (;;) {
        sum = 0u; cnt = 0u; mine = 0u;
#pragma unroll
        for (unsigned j = 0; j < 16; ++j) { const unsigned c = xb_ld(&bar[XB_XCNT(j)]); sum += c; cnt += (c > 0u) ? 1u : 0u; mine = (j == x) ? c : mine; }
        if (sum == G) break;
        __builtin_amdgcn_s_sleep(1);
        if ((++sp & 255u) == 0u) { if (xb_ld(&bar[XB_TMO])) break; if (sp > XB_SPIN_CAP) { atomicAdd(&bar[XB_TMO], 1u); break; } }
    }
    nloc = mine > 0u ? mine : 1u; nx = cnt > 0u ? cnt : 1u;
}
__device__ __forceinline__ void xcd_barrier(const XcdBarrier& b) {
    asm volatile("s_waitcnt vmcnt(0)" ::: "memory");
    __syncthreads();
    if (threadIdx.x == 0) {
        unsigned* bar = b.bar;
        __builtin_amdgcn_s_waitcnt(0);
        unsigned nloc = b.st[0], nx = b.st[1];
        if (nloc == 0u) { xcd_barrier_complete(bar, b.x, b.n, nloc, nx); b.st[0] = nloc; b.st[1] = nx; }
        const unsigned old = xb_add(&bar[XB_XSUB(b.x)], 1u);
        const unsigned gen = old / nloc;
        if (old + 1u == (gen + 1u) * nloc) {
            __builtin_amdgcn_fence(__ATOMIC_RELEASE, "agent");
            asm volatile("s_waitcnt vmcnt(0)" ::: "memory");
            const unsigned og = xb_add(&bar[XB_TOP], 1u);
            const unsigned tg = og / nx;
            if (og + 1u == (tg + 1u) * nx) xb_add(&bar[XB_TOPGEN], 1u);
            else XB_SPIN(xb_ld(&bar[XB_TOPGEN]) == tg, bar);
            __builtin_amdgcn_fence(__ATOMIC_ACQUIRE, "agent");
            xb_add(&bar[XB_XGEN(b.x)], 1u);
            asm volatile("s_waitcnt vmcnt(0)" ::: "memory");
        } else {
            XB_SPIN(xb_ld(&bar[XB_XGEN(b.x)]) == gen, bar);
            __builtin_amdgcn_fence(__ATOMIC_ACQUIRE, "agent");
            asm volatile("s_waitcnt vmcnt(0)" ::: "memory");
        }
    }
    __syncthreads();
}

struct Args {
    const float *x, *mem, *g_pre, *g_post, *g_mem, *w_in, *w_mkv, *vg, *vb, *wsp, *bsp, *sinks, *relb, *w_out;
    float* out; unsigned char* ws;
};

__device__ __forceinline__ void p0_transpose_item(const float* W, int K, int N, bf16_t* WT, int row_off, LAS float* scr, int item, int lane) {
    const int nblk = N / 32, kb = item / nblk, nb = item % nblk, k0 = 64 * kb, n0 = 32 * nb;
    float wv[32];
#pragma unroll
    for (int i = 0; i < 32; ++i) wv[i] = W[(size_t)(k0 + 2 * i + (lane >> 5)) * N + n0 + (lane & 31)];
#pragma unroll
    for (int i = 0; i < 32; ++i) scr[(2 * i + (lane >> 5)) * 33 + (lane & 31)] = wv[i];
    LDS_WAIT(); asm volatile("" ::: "memory");
    const int c = lane & 7;
#pragma unroll
    for (int j = 0; j < 4; ++j) { const int n = (lane >> 3) + 8 * j; const LAS float* s = scr + (8 * c) * 33 + n;
        v4u o; o.x = pk2(s[0 * 33], s[1 * 33]); o.y = pk2(s[2 * 33], s[3 * 33]); o.z = pk2(s[4 * 33], s[5 * 33]); o.w = pk2(s[6 * 33], s[7 * 33]);
        *(GAS v4u*)(WT + (size_t)(row_off + n0 + n) * K + k0 + 8 * c) = o; }
    LDS_WAIT(); asm volatile("" ::: "memory");
}
template <int NB> __device__ __forceinline__ void rms_rows_to_bf16(const float* src, const float* g, bf16_t* dst, int m0, int m1, int step, int lane) {
    if (m0 >= m1) return;
    const int mlast = m0 + ((m1 - 1 - m0) / step) * step;
    const int q0 = 2 * lane, q1 = 2 * (lane + 64);
    const GAS f32x4* gr = (const GAS f32x4*)g;
    const f32x4 gg[4] = {gr[q0], gr[q0 + 1], gr[q1], gr[q1 + 1]};
    f32x4 v[NB][4], nx[NB][4];
#pragma unroll
    for (int i = 0; i < NB; ++i) { const int mr = m0 + i * step < mlast ? m0 + i * step : mlast; const GAS f32x4* xr = (const GAS f32x4*)(src + (size_t)mr * D_MODEL);
        v[i][0] = __builtin_nontemporal_load(&xr[q0]); v[i][1] = __builtin_nontemporal_load(&xr[q0 + 1]); v[i][2] = __builtin_nontemporal_load(&xr[q1]); v[i][3] = __builtin_nontemporal_load(&xr[q1 + 1]); }
    for (int m = m0; m < m1; m += NB * step) {
#pragma unroll
        for (int i = 0; i < NB; ++i) { const int mn = m + (NB + i) * step, mr = mn < mlast ? mn : mlast; const GAS f32x4* xr = (const GAS f32x4*)(src + (size_t)mr * D_MODEL);
            nx[i][0] = __builtin_nontemporal_load(&xr[q0]); nx[i][1] = __builtin_nontemporal_load(&xr[q0 + 1]); nx[i][2] = __builtin_nontemporal_load(&xr[q1]); nx[i][3] = __builtin_nontemporal_load(&xr[q1 + 1]); }
#pragma unroll
        for (int i = 0; i < NB; ++i) {
            const int mi = m + i * step;
            float s = 0.f;
#pragma unroll
            for (int j = 0; j < 4; ++j) s += (v[i][j].x * v[i][j].x + v[i][j].y * v[i][j].y) + (v[i][j].z * v[i][j].z + v[i][j].w * v[i][j].w);
            const float r = rsqrtf(wave_sum(s) * (1.f / D_MODEL) + EPS);
            if (mi < m1) {
                GAS v4u* o16 = (GAS v4u*)(dst + (size_t)mi * D_MODEL);
#pragma unroll
                for (int k = 0; k < 2; ++k) { const f32x4 a = v[i][2 * k], b = v[i][2 * k + 1], ga = gg[2 * k], gb = gg[2 * k + 1]; v4u w;
                    w.x = pk2(a.x * r * ga.x, a.y * r * ga.y); w.y = pk2(a.z * r * ga.z, a.w * r * ga.w); w.z = pk2(b.x * r * gb.x, b.y * r * gb.y); w.w = pk2(b.z * r * gb.z, b.w * r * gb.w);
                    o16[lane + 64 * k] = w; }
            }
        }
#pragma unroll
        for (int i = 0; i < NB; ++i)
#pragma unroll
            for (int j = 0; j < 4; ++j) v[i][j] = nx[i][j];
    }
}

struct EpiProj {
    static constexpr bool PERM = true;
    bf16_t* PROJ; bf16_t* MKV; int pm_base, mem_pm0, mem_b0;
    template <int ACT> __device__ __forceinline__ void tile(const pg8::f32x4 (&acc)[2][2][4][2], bf16_t* b0, bf16_t* b1, int pitch) const {
#pragma unroll
        for (int ai = 0; ai < 2; ++ai)
#pragma unroll
            for (int m = 0; m < 4; ++m) { const size_t ro = (size_t)(ai * 128 + m * 16) * pitch;
#pragma unroll
                for (int bj = 0; bj < 2; ++bj) { f32x2 p[4];
#pragma unroll
                    for (int e = 0; e < 2; ++e) { p[e] = (f32x2){acc[ai][bj][m][0][2 * e], acc[ai][bj][m][0][2 * e + 1]}; p[2 + e] = (f32x2){acc[ai][bj][m][1][2 * e], acc[ai][bj][m][1][2 * e + 1]}; }
#pragma unroll
                    for (int e = 0; e < 4; ++e) { if (ACT == 1) p[e] = gelu_tanh_pk(p[e]); else if (ACT == 2) p[e] = p[e] * QSCALE; else if (ACT == 3) p[e] = silu_pk(p[e]); }
                    pg8::u32x4 w; w.x = pg8::cvt_pk_bf16(p[0].x, p[0].y); w.y = pg8::cvt_pk_bf16(p[1].x, p[1].y); w.z = pg8::cvt_pk_bf16(p[2].x, p[2].y); w.w = pg8::cvt_pk_bf16(p[3].x, p[3].y);
                    *(pg8::u32x4*)((bj ? b1 : b0) + ro) = w; } }
    }
    __device__ __forceinline__ void operator()(const pg8::f32x4 (&acc)[2][2][4][2], const pg8::Unit& u, int wr, int wc, int fr, int fq) const {
        const int c128 = wc * 32 + 8 * fq, c64 = (wc & 1) * 32 + 8 * fq, k64 = wc >> 1;
        if (u.pn < 11) {
            const size_t row = (size_t)(pm_base + u.pm) * 256 + wr * 64 + fr;
            if (u.pn < 4) {
                bf16_t* base = PROJ + (u.pn < 2 ? PU_OFF : PV_OFF) + (size_t)(2 * (u.pn & 1)) * MT * 128 + row * 128 + c128;
                tile<1>(acc, base, base + MT * 128, 128);
            } else if (u.pn == 4 || u.pn == 6) {
                bf16_t* base = PROJ + (u.pn == 4 ? PQ_OFF : PMQ_OFF) + (size_t)k64 * MT * 64 + row * 64 + c64;
                tile<2>(acc, base, base + 2 * MT * 64, 64);
            } else if (u.pn == 5) {
                bf16_t* base = PROJ + PK_OFF + (size_t)k64 * MT * 64 + row * 64 + c64;
                tile<0>(acc, base, base + (PVV_OFF - PK_OFF), 64);
            } else {
                bf16_t* base = PROJ + PZ_OFF + (size_t)(4 * (u.pn - 7) + k64) * MT * 64 + row * 64 + c64;
                tile<3>(acc, base, base + 2 * MT * 64, 64);
            }
        } else {
            const int b = mem_b0 + (u.pm - mem_pm0); const size_t key = (size_t)wr * 64 + fr;
            bf16_t* base = MKV + (u.pn - 11) * MV_OFF + ((size_t)(b * 4 + k64) * MEM_LEN + key) * 64 + c64;
            tile<0>(acc, base, base + (size_t)2 * MEM_LEN * 64, 64);
        }
    }
};
struct EpiOut {
    static constexpr bool PERM = true;
    bf16_t* O; float* SSP; int pm_base;
    __device__ __forceinline__ void operator()(const pg8::f32x4 (&acc)[2][2][4][2], const pg8::Unit& u, int wr, int wc, int fr, int fq) const {
        const int row0 = (pm_base + u.pm) * 256 + wr * 64 + fr, col0 = u.pn * 256 + wc * 32 + 8 * fq;
#pragma unroll
        for (int ai = 0; ai < 2; ++ai)
#pragma unroll
            for (int m = 0; m < 4; ++m) { const int row = row0 + ai * 128 + m * 16; bf16_t* rowp = O + (size_t)row * D_MODEL + col0; float ss = 0.f;
#pragma unroll
                for (int bj = 0; bj < 2; ++bj) { const pg8::f32x4 v0 = acc[ai][bj][m][0], v1 = acc[ai][bj][m][1];
                    ss += (v0[0] * v0[0] + v0[1] * v0[1]) + (v0[2] * v0[2] + v0[3] * v0[3]) + (v1[0] * v1[0] + v1[1] * v1[1]) + (v1[2] * v1[2] + v1[3] * v1[3]);
                    pg8::u32x4 w; w.x = pg8::cvt_pk_bf16(v0[0], v0[1]); w.y = pg8::cvt_pk_bf16(v0[2], v0[3]); w.z = pg8::cvt_pk_bf16(v1[0], v1[1]); w.w = pg8::cvt_pk_bf16(v1[2], v1[3]);
                    *(pg8::u32x4*)(rowp + bj * 128) = w; }
                ss += __shfl_xor(ss, 16); ss += __shfl_xor(ss, 32);
                if (fq == 0) SSP[(size_t)row * 16 + u.pn * 4 + wc] = ss; }
    }
};

__device__ __forceinline__ int t5_bucket(int n) {
    if (n < 16) return n;
    int l = 16 + (int)(__logf((float)n * (1.f / 16.f)) * (16.f / 2.0794415416798357f));
    return l < 31 ? l : 31;
}

namespace mix {
typedef short bf16x8 __attribute__((ext_vector_type(8)));
typedef short s16x4 __attribute__((ext_vector_type(4)));
typedef float f32x16 __attribute__((ext_vector_type(16)));
typedef unsigned u32x4 __attribute__((ext_vector_type(4)));
typedef float f32x2_t __attribute__((ext_vector_type(2))); typedef __bf16 bf16x2_t __attribute__((ext_vector_type(2)));
constexpr int L1_OFF = 33280, STG_OFF = 66560, STG_WAVE = 8192, BIAS_OFF = 132096  , WSF_OFF = 136192, BSP_OFF = 138752  , VGB_OFF = 140800  ;
constexpr int SWA_VSTR = 256 * 64 + 64;
constexpr int X_KH = 16384, X_VH = 16512, X_VSTR = 128 * 64 + 64;
constexpr int G_GRP = 16640, G_CSTR = 64 * 64 + 64;

__device__ __forceinline__ int crow(int r, int hi) { return (r & 3) + 8 * (r >> 2) + 4 * hi; }
__device__ __forceinline__ s16x4 vtr(const LAS unsigned char* p) { return __builtin_bit_cast(s16x4, __builtin_amdgcn_ds_read_tr16_b64_v4i16((LAS s16x4*)p)); }
__device__ __forceinline__ unsigned cvtpk(float lo, float hi) { f32x2_t v = {lo, hi}; bf16x2_t b = __builtin_convertvector(v, bf16x2_t); return __builtin_bit_cast(unsigned, b); }
__device__ __forceinline__ u32x4 mul8(u32x4 a, u32x4 b) { u32x4 r;
#pragma unroll
    for (int e = 0; e < 4; ++e) r[e] = cvtpk(bflo(a[e]) * bflo(b[e]), bfhi(a[e]) * bfhi(b[e]));
    return r; }
__device__ __forceinline__ u32x4 mul8x3(u32x4 a, u32x4 b, u32x4 c) { u32x4 r;
#pragma unroll
    for (int e = 0; e < 4; ++e) r[e] = cvtpk(bflo(a[e]) * bflo(b[e]) * bflo(c[e]), bfhi(a[e]) * bfhi(b[e]) * bfhi(c[e]));
    return r; }

__device__ __forceinline__ f32x16 qk_block(const LAS unsigned char* Kt, int key0, const bf16x8 (&qf)[4], int r32, int hi, f32x16 s) {
    const int key = key0 + r32, sw = (key >> 1) & 7; const LAS unsigned char* kr = Kt + key * 128;
#pragma unroll
    for (int d0 = 0; d0 < 4; ++d0) { const bf16x8 kf = *(const LAS bf16x8*)(kr + (((2 * d0 + hi) ^ sw) << 4)); s = __builtin_amdgcn_mfma_f32_32x32x16_bf16(kf, qf[d0], s, 0, 0, 0); }
    return s;
}
__device__ __forceinline__ void pv_block(f32x16 (&o)[2], const f32x16& p, const LAS unsigned char* Vt, int vstr, int key0, int lane) {
    const LAS unsigned char* vb = Vt + (key0 + 4 * (lane >> 5) + ((lane >> 2) & 3)) * 64 + ((lane >> 4) & 1) * 32 + (lane & 3) * 8;
#pragma unroll
    for (int s = 0; s < 2; ++s) {
        u32x4 pw; pw[0] = cvtpk(p[8 * s + 0], p[8 * s + 1]); pw[1] = cvtpk(p[8 * s + 2], p[8 * s + 3]); pw[2] = cvtpk(p[8 * s + 4], p[8 * s + 5]); pw[3] = cvtpk(p[8 * s + 6], p[8 * s + 7]);
        const bf16x8 pa = __builtin_bit_cast(bf16x8, pw);
#pragma unroll
        for (int dblk = 0; dblk < 2; ++dblk) {
            const s16x4 lo = vtr(vb + dblk * vstr + s * 1024), hi4 = vtr(vb + dblk * vstr + s * 1024 + 512);
            const bf16x8 vf = {lo[0], lo[1], lo[2], lo[3], hi4[0], hi4[1], hi4[2], hi4[3]};
            o[dblk] = __builtin_amdgcn_mfma_f32_32x32x16_bf16(pa, vf, o[dblk], 0, 0, 0);
        }
    }
}
struct TileSrc { const bf16_t* p; long s_hi; };
__device__ __forceinline__ void load_half(u32x4 (&r)[4], const TileSrc t, int tid) {
    const bf16_t* p = t.p + (long)tid * 8;
#pragma unroll
    for (int it = 0; it < 4; ++it) r[it] = *(const u32x4*)(p + (it >> 1) * t.s_hi + (it & 1) * 4096);
}
__device__ __forceinline__ void write_k(const u32x4 (&r)[4], LAS unsigned char* L, bool zero_lo, int tid) {
    const int ch = tid & 7, kl = tid >> 3; LAS unsigned char* d = L + kl * 128 + ((ch ^ ((kl >> 1) & 7)) << 4);
    const unsigned keep = zero_lo ? 0u : 0xffffffffu;
#pragma unroll
    for (int it = 0; it < 4; ++it) { u32x4 v = r[it]; if (it < 2) { v[0] &= keep; v[1] &= keep; v[2] &= keep; v[3] &= keep; } *(LAS u32x4*)(d + it * 8192) = v; }
}
__device__ __forceinline__ void write_v_swa(const u32x4 (&r)[4], LAS unsigned char* L, bool zero_lo, int tid) {
    const int ch = tid & 7, kl = tid >> 3; LAS unsigned char* d = L + (ch >> 2) * SWA_VSTR + kl * 64 + (ch & 3) * 16;
    const unsigned keep = zero_lo ? 0u : 0xffffffffu;
#pragma unroll
    for (int it = 0; it < 4; ++it) { u32x4 v = r[it]; if (it < 2) { v[0] &= keep; v[1] &= keep; v[2] &= keep; v[3] &= keep; } *(LAS u32x4*)(d + it * 4096) = v; }
}
__device__ __forceinline__ void write_v_x(const u32x4 (&r)[4], LAS unsigned char* L, int tid) {
    const int ch = tid & 7, kl = tid >> 3; LAS unsigned char* d = L + (ch >> 2) * X_VSTR + kl * 64 + (ch & 3) * 16;
#pragma unroll
    for (int it = 0; it < 4; ++it) *(LAS u32x4*)(d + (it >> 1) * X_VH + (it & 1) * 4096) = r[it];
}
__device__ __forceinline__ float row16_sum(float v) {
    v += __shfl_xor(v, 1); v += __shfl_xor(v, 2); v += __shfl_xor(v, 4); v += __shfl_xor(v, 8);
    return v;
}
__device__ __forceinline__ void write_g(const u32x4 (&r)[4], LAS unsigned char* L, const LAS float* vgb, int gp, int tid) {
    const int ch = tid & 15;
#pragma unroll
    for (int it = 0; it < 4; ++it) { const int gl = it >> 1, srow = (it & 1) * 32 + (tid >> 4), g = 2 * gp + gl;
        float v[8];
#pragma unroll
        for (int e = 0; e < 4; ++e) { v[2 * e] = bflo(r[it][e]); v[2 * e + 1] = bfhi(r[it][e]); }
        const float mu = row16_sum(((v[0] + v[1]) + (v[2] + v[3])) + ((v[4] + v[5]) + (v[6] + v[7]))) * (1.f / 128.f); float sq = 0.f;
#pragma unroll
        for (int e = 0; e < 8; ++e) { v[e] -= mu; sq += v[e] * v[e]; }
        const float rs = rsqrtf(row16_sum(sq) * (1.f / 128.f) + EPS);
        const LAS f32x4* gq = (const LAS f32x4*)(vgb + g * 128 + ch * 8); const LAS f32x4* bq = (const LAS f32x4*)(vgb + 512 + g * 128 + ch * 8);
        const f32x4 g0 = gq[0], g1 = gq[1], b0 = bq[0], b1 = bq[1];
        u32x4 w;
        w[0] = cvtpk(v[0] * rs * g0[0] + b0[0], v[1] * rs * g0[1] + b0[1]); w[1] = cvtpk(v[2] * rs * g0[2] + b0[2], v[3] * rs * g0[3] + b0[3]);
        w[2] = cvtpk(v[4] * rs * g1[0] + b1[0], v[5] * rs * g1[1] + b1[1]); w[3] = cvtpk(v[6] * rs * g1[2] + b1[2], v[7] * rs * g1[3] + b1[3]);
        *(LAS u32x4*)(L + gl * G_GRP + (ch >> 2) * G_CSTR + srow * 64 + (ch & 3) * 16) = w; }
}
__device__ __forceinline__ void attn_out(const f32x16 (&o)[2], float rinv_q, LAS unsigned char* stg, LAS float* wsf, const u32x4 (&zv)[4], bf16_t* yrow0, int lane) {
    const int r32 = lane & 31, hi = lane >> 5;
    if (hi == 0) wsf[r32] = rinv_q;
    LDS_WAIT();
    LAS bf16_t* st = (LAS bf16_t*)stg;
#pragma unroll
    for (int r = 0; r < 16; ++r) { const int q = crow(r, hi); const float ri = wsf[q];
        st[q * 64 + r32] = (bf16_t)f2bf(o[0][r] * ri); st[q * 64 + 32 + r32] = (bf16_t)f2bf(o[1][r] * ri); }
    LDS_WAIT();
#pragma unroll
    for (int i = 0; i < 4; ++i) { const int row = i * 8 + (lane >> 3), ch = lane & 7;
        const u32x4 v = *(const LAS u32x4*)(stg + row * 128 + ch * 16);
        *(u32x4*)(yrow0 + (size_t)row * D_MODEL + ch * 8) = mul8(v, zv[i]); }
    LDS_WAIT();
}
__device__ __forceinline__ void load_z4(u32x4 (&zv)[4], const bf16_t* zrow0, int lane) {
#pragma unroll
    for (int i = 0; i < 4; ++i) zv[i] = __builtin_nontemporal_load((const u32x4*)(zrow0 + (size_t)(i * 8 + (lane >> 3)) * 64 + (lane & 7) * 8));
}
__device__ __forceinline__ void load_q4(bf16x8 (&q)[4], const bf16_t* qp) {
#pragma unroll
    for (int d0 = 0; d0 < 4; ++d0) q[d0] = *(const bf16x8*)(qp + 16 * d0);
}

__device__ __forceinline__ void mix_unit(int unit, LAS unsigned char* lds, const bf16_t* __restrict__ PROJ, const bf16_t* __restrict__ MKV, const bf16_t* __restrict__ WSP, bf16_t* __restrict__ Y, int tid, int wave) {
    const int b = unit >> 4, n = unit & 15, rb = wave & 3, wh = wave >> 2;
    const size_t row0 = (size_t)b * SEQ + (size_t)n * CHUNK;
    const size_t wrow0 = row0 + 32 * rb;
    LAS unsigned char* const L0 = lds; LAS unsigned char* const L1 = lds + L1_OFF;
    LAS unsigned char* stg = lds + STG_OFF + wave * STG_WAVE;
    LAS float* wsf = (LAS float*)(lds + WSF_OFF) + wave * 64;
    const LAS float* btab = (const LAS float*)(lds + BIAS_OFF);
    const LAS float* bstab = (const LAS float*)(lds + BSP_OFF);
    const LAS float* vgb = (const LAS float*)(lds + VGB_OFF);
    const int tid_in = tid;
    const bool first = (n == 0);
#define MIX_BAR() asm volatile("s_waitcnt lgkmcnt(0)\n\ts_barrier" ::: "memory")
#define MIX_LANES() int tid = tid_in; asm volatile("" : "+v"(tid)); const int lane = tid & 63, r32 = lane & 31, hi = lane >> 5; const size_t qoff = (wrow0 + r32) * 64 + 8 * hi;
    auto tile_src = [&](int j) -> TileSrc {
        TileSrc t; j = j > 15 ? 15 : j;
        if (j < 4) { t.p = PROJ + ((j & 1) ? PVV_OFF : PK_OFF) + (size_t)(j >> 1) * MT * 64 + ((long)row0 - 128) * 64; t.s_hi = 8192; }
        else if (j < 12) { const int x = j - 4, st = x >> 1; t.p = MKV + ((x & 1) ? MV_OFF : 0) + ((size_t)(b * 4 + 2 * (st >> 1)) * MEM_LEN + (st & 1) * 128) * 64; t.s_hi = (long)MEM_LEN * 64; }
        else { const int y = j - 12; t.p = PROJ + PV_OFF + (size_t)(2 * (y >> 1)) * MT * 128 + (row0 + (y & 1) * 64) * 128; t.s_hi = (long)MT * 128; }
        return t; };
    u32x4 R0[4], R1[4]; bf16x8 qf[4];
    { MIX_LANES();
      load_half(R0, tile_src(0), tid); load_q4(qf, PROJ + PQ_OFF + (size_t)wh * MT * 64 + qoff);
      MIX_BAR();
      write_k(R0, L0, first, tid);
      load_half(R1, tile_src(1), tid); load_half(R0, tile_src(2), tid); }

#pragma unroll 1
    for (int kvh = 0; kvh < 2; ++kvh) {
        const int h = 2 * kvh + wh, j = 2 * kvh;
        f32x16 s[5]; float rinv; u32x4 zv[4];
        { MIX_LANES(); (void)qoff;
          MIX_BAR();
          write_v_swa(R1, L1, first, tid);
          load_z4(zv, PROJ + PZ_OFF + (size_t)(8 + h) * MT * 64 + wrow0 * 64, lane);
          load_half(R1, tile_src(j + 3), tid);
#pragma unroll
          for (int t = 0; t < 5; ++t) {
              const LAS float* tb = btab + ((first && rb + t < 4) ? 4 : h) * 192 + (31 - r32 + 4 * hi);
#pragma unroll
              for (int r = 0; r < 16; ++r) s[t][r] = tb[32 * t + (r & 3) + 8 * (r >> 2)];
          }
#pragma unroll
          for (int t = 0; t < 5; ++t) s[t] = qk_block(L0, 32 * (rb + t), qf, r32, hi, s[t]);
          const float sink2 = btab[5 * 192 + h]; float m = sink2;
#pragma unroll
          for (int t = 0; t < 5; ++t)
#pragma unroll
              for (int r = 0; r < 16; ++r) m = fmaxf(m, s[t][r]);
          m = fmaxf(m, __shfl_xor(m, 32));
          float l = 0.f;
#pragma unroll
          for (int t = 0; t < 5; ++t)
#pragma unroll
              for (int r = 0; r < 16; ++r) { const float p = __builtin_amdgcn_exp2f(s[t][r] - m); s[t][r] = p; l += p; }
          l += __shfl_xor(l, 32);
          rinv = __builtin_amdgcn_rcpf(l + __builtin_amdgcn_exp2f(sink2 - m)); }
        { MIX_LANES();
          MIX_BAR();
          write_k(R0, L0, kvh == 0 && first, tid);
          load_q4(qf, PROJ + (kvh == 0 ? PQ_OFF + (size_t)(2 + wh) * MT * 64 : PMQ_OFF + (size_t)wh * MT * 64) + qoff);
          load_half(R0, tile_src(j + 4), tid);
          f32x16 o[2] = {};
#pragma unroll
          for (int t = 0; t < 5; ++t) pv_block(o, s[t], L1, SWA_VSTR, 32 * (rb + t), lane);
          attn_out(o, rinv, stg, wsf, zv, Y + wrow0 * D_MODEL + 512 + h * 64, lane); }
    }
    {
        float m = -INFINITY, l = 0.f; f32x16 o[2] = {};
#pragma unroll 1
        for (int st = 0; st < 4; ++st) {
            const int hp = st >> 1, half = st & 1, h = 2 * hp + wh, j = 4 + 2 * st;
            f32x16 s[4]; float f; u32x4 zv[4];
            { MIX_LANES(); (void)qoff;
              if (half == 0) { m = -INFINITY; l = 0.f; o[0] = (f32x16){}; o[1] = (f32x16){}; }
              MIX_BAR();
              write_v_x(R1, L1, tid);
              load_z4(zv, PROJ + PZ_OFF + (size_t)(12 + h) * MT * 64 + wrow0 * 64, lane);
              load_half(R1, tile_src(j + 3), tid);
              const LAS unsigned char* Kt = L0 + wh * X_KH;
#pragma unroll
              for (int t = 0; t < 4; ++t) s[t] = qk_block(Kt, 32 * t, qf, r32, hi, (f32x16){});
              float mloc = -INFINITY;
#pragma unroll
              for (int t = 0; t < 4; ++t)
#pragma unroll
                  for (int r = 0; r < 16; ++r) mloc = fmaxf(mloc, s[t][r]);
              mloc = fmaxf(mloc, __shfl_xor(mloc, 32));
              const float mn = fmaxf(m, mloc); f = __builtin_amdgcn_exp2f(m - mn);
              float ls = 0.f;
#pragma unroll
              for (int t = 0; t < 4; ++t)
#pragma unroll
                  for (int r = 0; r < 16; ++r) { const float p = __builtin_amdgcn_exp2f(s[t][r] - mn); s[t][r] = p; ls += p; }
              ls += __shfl_xor(ls, 32);
              l = l * f + ls; m = mn; }
            { MIX_LANES();
              MIX_BAR();
              if (st < 3) write_k(R0, L0, false, tid); else write_g(R0, L0, vgb, 0, tid);
              load_q4(qf, PROJ + PMQ_OFF + (size_t)(2 * (st < 3 ? ((st + 1) >> 1) : hp) + wh) * MT * 64 + qoff);
              load_half(R0, tile_src(j + 4), tid);
              if (half == 1) {
                  if (hi == 0) wsf[r32] = f;
                  LDS_WAIT();
#pragma unroll
                  for (int r = 0; r < 16; ++r) { const float fr = wsf[crow(r, hi)]; o[0][r] *= fr; o[1][r] *= fr; }
                  LDS_WAIT();
              }
              const LAS unsigned char* Vt = L1 + wh * X_VH;
#pragma unroll
              for (int t = 0; t < 4; ++t) pv_block(o, s[t], Vt, X_VSTR, 32 * t, lane);
              if (half == 1) attn_out(o, __builtin_amdgcn_rcpf(l), stg, wsf, zv, Y + wrow0 * D_MODEL + 768 + h * 64, lane); }
        }
    }
#pragma unroll 1
    for (int gp = 0; gp < 2; ++gp) {
        const int g = 2 * gp + wh, nks = 2 * rb + 2, j = 12 + 2 * gp;
        f32x16 acc[4] = {}; u32x4 uv[8], zv[8]; bf16x8 af[8];
        { MIX_LANES(); (void)qoff;
          const bf16_t* wrow = WSP + ((size_t)(g * 128 + 32 * rb + r32)) * 128 + 8 * hi;
#pragma unroll
          for (int ks = 0; ks < 8; ++ks) af[ks] = *(const bf16x8*)(wrow + 16 * ks);
          MIX_BAR();
          write_g(R1, L1, vgb, gp, tid);
#pragma unroll
          for (int i = 0; i < 8; ++i) { const size_t row = wrow0 + i * 4 + (lane >> 4); const int ch = lane & 15;
              uv[i] = __builtin_nontemporal_load((const u32x4*)(PROJ + PU_OFF + (size_t)g * MT * 128 + row * 128 + ch * 8));
              zv[i] = __builtin_nontemporal_load((const u32x4*)(PROJ + PZ_OFF + (size_t)(2 * g + (ch >> 3)) * MT * 64 + row * 64 + (ch & 7) * 8)); }
          load_half(R1, tile_src(j + 3), tid);
          const LAS unsigned char* tb = L0 + wh * G_GRP + (8 * hi + ((lane >> 2) & 3)) * 64 + ((lane >> 4) & 1) * 32 + (lane & 3) * 8;
#pragma unroll
          for (int ks = 0; ks < 4; ++ks) if (ks < nks) {
#pragma unroll
              for (int cb = 0; cb < 4; ++cb) {
                  const s16x4 lo = vtr(tb + cb * G_CSTR + ks * 1024), hi4 = vtr(tb + cb * G_CSTR + ks * 1024 + 256);
                  const bf16x8 bfv = {lo[0], lo[1], lo[2], lo[3], hi4[0], hi4[1], hi4[2], hi4[3]};
                  acc[cb] = __builtin_amdgcn_mfma_f32_32x32x16_bf16(af[ks], bfv, acc[cb], 0, 0, 0);
              }
          } }
        { MIX_LANES(); (void)qoff;
          MIX_BAR();
          if (gp == 0) write_g(R0, L0, vgb, 1, tid);
          load_half(R0, tile_src(j + 4), tid);
          const LAS unsigned char* tb = L1 + wh * G_GRP + (8 * hi + ((lane >> 2) & 3)) * 64 + ((lane >> 4) & 1) * 32 + (lane & 3) * 8;
#pragma unroll
          for (int ks = 4; ks < 8; ++ks) if (ks < nks) {
#pragma unroll
              for (int cb = 0; cb < 4; ++cb) {
                  const s16x4 lo = vtr(tb + cb * G_CSTR + (ks - 4) * 1024), hi4 = vtr(tb + cb * G_CSTR + (ks - 4) * 1024 + 256);
                  const bf16x8 bfv = {lo[0], lo[1], lo[2], lo[3], hi4[0], hi4[1], hi4[2], hi4[3]};
                  acc[cb] = __builtin_amdgcn_mfma_f32_32x32x16_bf16(af[ks], bfv, acc[cb], 0, 0, 0);
              }
          }
          LAS bf16_t* st = (LAS bf16_t*)stg;
#pragma unroll
          for (int r = 0; r < 16; ++r) { const int t = crow(r, hi); const float bs = bstab[g * 128 + 32 * rb + t];
#pragma unroll
              for (int cb = 0; cb < 4; ++cb) st[t * 128 + cb * 32 + r32] = (bf16_t)f2bf(acc[cb][r] + bs); }
          LDS_WAIT();
#pragma unroll
          for (int i = 0; i < 8; ++i) { const int row = i * 4 + (lane >> 4), ch = lane & 15;
              const u32x4 sv = *(const LAS u32x4*)(stg + row * 256 + ch * 16);
              *(u32x4*)(Y + (wrow0 + row) * D_MODEL + g * 128 + ch * 8) = mul8x3(sv, uv[i], zv[i]); }
          LDS_WAIT(); }
    }
    { MIX_BAR(); }
#undef MIX_LANES
#undef MIX_BAR
}
}

__global__ void __launch_bounds__(NWAVES * 64, 2) hymba_fwd(Args args) {
    extern __shared__ __attribute__((aligned(16))) unsigned char lds_raw[];
    LAS unsigned char* lds = (LAS unsigned char*)lds_raw;
    volatile LAS unsigned* MISC = (volatile LAS unsigned*)(lds + MISC_OFF);
    const int tid = threadIdx.x, lane = tid & 63, wave = __builtin_amdgcn_readfirstlane(tid >> 6);
    const int G = gridDim.x; const int bx = blockIdx.x; const int vcu = (G % 8 == 0) ? (bx % 8) * (G / 8) + bx / 8 : bx;
    unsigned char* ws = args.ws;
    unsigned* ctl = (unsigned*)(ws + WS_CTL);
    bf16_t* WIN_T = (bf16_t*)(ws + WS_WIN); bf16_t* WOUT_T = (bf16_t*)(ws + WS_WOUT); bf16_t* WSP = (bf16_t*)(ws + WS_WSP); float* SSP = (float*)(ws + WS_SSP);
    bf16_t* XN = (bf16_t*)(ws + WS_XN); bf16_t* PROJ = (bf16_t*)(ws + WS_PROJ); bf16_t* MKV = (bf16_t*)(ws + WS_MKV); bf16_t* Y = (bf16_t*)(ws + WS_Y); bf16_t* O = (bf16_t*)(ws + WS_O);
    for (int u = tid; u < (LDS_BYTES - LDSCTL_OFF) / 4; u += NWAVES * 64) ((LAS unsigned*)(lds + LDSCTL_OFF))[u] = 0u;
    __syncthreads();
    const int NG = (G == 256) ? 2 : 1, Gg = G / NG, grp = bx / Gg, cg = bx - grp * Gg;
    const int vcug = (Gg % 8 == 0) ? (cg % 8) * (Gg / 8) + cg / 8 : cg;
    const int MH = M_TOK / NG, MMH = M_MEM / NG, row_base = grp * MH, pm_base = row_base / 256;
    XcdBarrier barG = xcd_barrier_post(ctl + CW_BAR, MISC + 8, (unsigned)G);
    XcdBarrier barH = barG;
    if (NG == 2) barH = xcd_barrier_post(ctl + CW_BAR + (1 + grp) * XCD_BAR_WORDS, MISC + 10, (unsigned)Gg);
    const int gw = vcu * NWAVES + wave, NGW = G * NWAVES, gwg = vcug * NWAVES + wave, NGWg = Gg * NWAVES;

    {
        rms_rows_to_bf16<4>(args.x, args.g_pre, XN, gw, MH, NGW, lane);
        rms_rows_to_bf16<2>(args.mem, args.g_mem, XN + (size_t)M_TOK * D_MODEL, gw, M_MEM, NGW, lane);
        LAS float* scr = (LAS float*)(lds + wave * 16384);
        constexpr int I_IN = (D_MODEL / 64) * (IN_WIDTH / 32), I_MKV = (D_MODEL / 64) * (MKV_W / 32), I_OUT = (D_MODEL / 64) * (D_MODEL / 32);
        for (int it = NGW - 1 - gw; it < I_IN + I_MKV + I_OUT; it += NGW) {
            int r = it;
            if (r < I_IN) { p0_transpose_item(args.w_in, D_MODEL, IN_WIDTH, WIN_T, 0, scr, r, lane); continue; } r -= I_IN;
            if (r < I_MKV) { p0_transpose_item(args.w_mkv, D_MODEL, MKV_W, WIN_T, IN_WIDTH, scr, r, lane); continue; } r -= I_MKV;
            p0_transpose_item(args.w_out, D_MODEL, D_MODEL, WOUT_T, 0, scr, r, lane);
        }
        for (int e = bx * 512 + tid; e < 4 * 128 * 128; e += G * 512) { const int s = e & 127, t = (e >> 7) & 127; WSP[e] = (bf16_t)f2bf(s <= t ? args.wsp[e] : 0.f); }
        xcd_barrier(barG);
    }
    if (grp == 1) {
        rms_rows_to_bf16<4>(args.x + (size_t)row_base * D_MODEL, args.g_pre, XN + (size_t)row_base * D_MODEL, gwg, MH, NGWg, lane);
        xcd_barrier(barH);
    }
    {
        pg8::Gemm g{XN + (size_t)row_base * D_MODEL, WIN_T, MH, IN_WIDTH + MKV_W, D_MODEL};
        pg8::MergedOrder S; S.S.init(MH, IN_WIDTH, Gg, cg, NG == 2 ? 4 : 8); S.eM = MMH / 256; S.eN = MKV_W / 256; S.ePm0 = (M_TOK + grp * MMH - row_base) / 256;
        EpiProj E{PROJ, MKV, pm_base, S.ePm0, grp * (BATCH / NG)};
        pg8::gemm_phase<EpiProj, pg8::MergedOrder, true, true>(lds, g, S, E);
        xcd_barrier(barH);
    }
    {
        for (int idx = tid; idx < 5 * 192; idx += NWAVES * 64) { const int h = idx / 192, dist = 159 - (idx % 192);
            ((LAS float*)(lds + mix::BIAS_OFF))[idx] = (h < 4 && dist >= 0 && dist < 128) ? args.relb[t5_bucket(dist) * 4 + h] * LOG2E : -INFINITY; }
        if (tid < 4) ((LAS float*)(lds + mix::BIAS_OFF))[5 * 192 + tid] = args.sinks[tid] * LOG2E;
        ((LAS float*)(lds + mix::BSP_OFF))[tid] = args.bsp[tid];
        ((LAS float*)(lds + mix::VGB_OFF))[tid] = args.vg[tid]; ((LAS float*)(lds + mix::VGB_OFF))[512 + tid] = args.vb[tid];
        __syncthreads();
        const int nu = BATCH * (SEQ / CHUNK) / NG;
        for (int u = vcug; u < nu; u += Gg) mix::mix_unit(grp * nu + u, lds, PROJ, MKV, WSP, Y, tid, wave);
        xcd_barrier(barH);
    }
    {
        pg8::Gemm g{Y + (size_t)row_base * D_MODEL, WOUT_T, MH, D_MODEL, D_MODEL};
        pg8::StaticOrder S; S.init(MH, D_MODEL, Gg, cg, NG == 2 ? 4 : 8);
        EpiOut E{O, SSP, pm_base};
        pg8::gemm_phase<EpiOut, pg8::StaticOrder, true, true>(lds, g, S, E);
        xcd_barrier(barH);
    }
    {
        const GAS f32x4* gp = (const GAS f32x4*)args.g_post + lane;
        f32x4 gg[4];
#pragma unroll
        for (int j = 0; j < 4; ++j) gg[j] = gp[64 * j];
        constexpr int NB = 4;
        const int m_end = row_base + MH;
        for (int m0 = row_base + gwg; m0 < m_end; m0 += NB * NGWg) {
            v2u ov[NB][4]; f32x4 xv[NB][4]; float ssp[NB];
#pragma unroll
            for (int i = 0; i < NB; ++i) { const int m = (m0 + i * NGWg < m_end) ? m0 + i * NGWg : m0;
                const GAS v2u* orow = (const GAS v2u*)(O + (size_t)m * D_MODEL) + lane; const GAS f32x4* xr = (const GAS f32x4*)(args.x + (size_t)m * D_MODEL) + lane;
#pragma unroll
                for (int j = 0; j < 4; ++j) { ov[i][j] = __builtin_nontemporal_load(&orow[64 * j]); xv[i][j] = __builtin_nontemporal_load(&xr[64 * j]); }
                ssp[i] = SSP[(size_t)m * 16 + (lane & 15)]; }
#pragma unroll
            for (int i = 0; i < NB; ++i) { const int m = m0 + i * NGWg;
                const float r = rsqrtf(wave_sum(ssp[i]) * 0.25f * (1.f / D_MODEL) + EPS);
                if (m < m_end) {
                    GAS f32x4* outr = (GAS f32x4*)(args.out + (size_t)m * D_MODEL) + lane;
#pragma unroll
                    for (int j = 0; j < 4; ++j) { f32x4 o;
                        o.x = xv[i][j].x + bflo(ov[i][j].x) * r * gg[j].x; o.y = xv[i][j].y + bfhi(ov[i][j].x) * r * gg[j].y; o.z = xv[i][j].z + bflo(ov[i][j].y) * r * gg[j].z; o.w = xv[i][j].w + bfhi(ov[i][j].y) * r * gg[j].w;
                        __builtin_nontemporal_store(o, &outr[64 * j]); }
                }
            }
        }
    }
}

extern "C" void kernel_launch(void* const* d_in, const int* in_sizes, int n_in, void* d_out, int out_size, void* d_ws, size_t ws_size, hipStream_t stream) {
    static int grid = 0;
    if (grid == 0) {
        if (n_in != 14 || in_sizes[0] != M_TOK * D_MODEL || out_size != M_TOK * D_MODEL || ws_size < WS_END) { fprintf(stderr, "kernel_launch: unexpected shapes (n_in %d, ws %zu)\n", n_in, ws_size); grid = -1; return; }
        int dev = 0, cus = 0, per_cu = 0;
        if (hipGetDevice(&dev) != hipSuccess || hipDeviceGetAttribute(&cus, hipDeviceAttributeMultiprocessorCount, dev) != hipSuccess) { grid = -1; return; }
        if (hipFuncSetAttribute((const void*)hymba_fwd, hipFuncAttributeMaxDynamicSharedMemorySize, LDS_BYTES) != hipSuccess) { fprintf(stderr, "kernel_launch: hipFuncSetAttribute failed\n"); grid = -1; return; }
        if (hipOccupancyMaxActiveBlocksPerMultiprocessor(&per_cu, (const void*)hymba_fwd, NWAVES * 64, LDS_BYTES) != hipSuccess || per_cu < 1) { fprintf(stderr, "kernel_launch: occupancy query says %d blocks/CU\n", per_cu); per_cu = 1; }
        (void)hipGetLastError();
        grid = cus;
    }
    if (grid < 0) return;
    (void)hipMemsetAsync((char*)d_ws + WS_CTL, 0, CTL_ZERO_BYTES, stream);
    Args a{};
    a.x = (const float*)d_in[0]; a.mem = (const float*)d_in[1]; a.g_pre = (const float*)d_in[2]; a.g_post = (const float*)d_in[3]; a.g_mem = (const float*)d_in[4];
    a.w_in = (const float*)d_in[5]; a.w_mkv = (const float*)d_in[6]; a.vg = (const float*)d_in[7]; a.vb = (const float*)d_in[8]; a.wsp = (const float*)d_in[9]; a.bsp = (const float*)d_in[10];
    a.sinks = (const float*)d_in[11]; a.relb = (const float*)d_in[12]; a.w_out = (const float*)d_in[13];
    a.out = (float*)d_out; a.ws = (unsigned char*)d_ws;
    hipLaunchKernelGGL(hymba_fwd, dim3(grid), dim3(NWAVES * 64), LDS_BYTES, stream, a);
}
```

```cpp
#include <hip/hip_runtime.h>
#include <cstdio>
#include <cstdint>

namespace pg8 {
#define PG8_LAS __attribute__((address_space(3)))
typedef unsigned short bf16_t;
typedef short bf16x8 __attribute__((ext_vector_type(8)));
typedef float f32x4 __attribute__((ext_vector_type(4)));
typedef unsigned u32x4 __attribute__((ext_vector_type(4)));
constexpr int BM = 256, BK = 64, HALF = 128, HTB = HALF * BK * 2, STAGE_BYTES = 8 * HTB, NXCD = 8, WGM = 8;

__host__ __device__ __forceinline__ int lds_byte(int r, int c) { const int st = (r >> 4) * 2 + (c >> 5), rr = r & 15, cc = c & 31, ob = rr * 64 + cc * 2; return st * 1024 + (ob ^ (((ob >> 9) & 1) << 5)); }
__host__ __device__ __forceinline__ void stage_rc(int b, int& R, int& C) { const int st = b / 1024, sb = b % 1024, swz = sb ^ (((sb >> 9) & 1) << 5); R = (st >> 1) * 16 + swz / 64; C = (st & 1) * 32 + (swz % 64) / 2; }
__host__ __device__ __forceinline__ int perm32(int rho) { const int n = rho >> 4, i = rho & 15; return 8 * (i >> 2) + 4 * n + (i & 3); }

struct Unit { int pm, pn; };
struct Gemm { const bf16_t* A; const bf16_t* Bt; int M, N, K; };

struct StaticOrder {
    int nM, nN, nwg, G, c, wgm;
    __host__ __device__ void init(int M, int N, int G_, int c_, int wgm_ = WGM) { nM = M / BM; nN = N / BM; nwg = nM * nN; G = G_; c = c_; wgm = wgm_; }
    __host__ __device__ void map(int wgid, Unit& u) const {
        { const int q = nwg / NXCD, r = nwg % NXCD, xcd = wgid % NXCD, off = wgid / NXCD; wgid = (xcd < r ? xcd * (q + 1) : r * (q + 1) + (xcd - r) * q) + off; }
        const int nig = wgm * nN, gid = wgid / nig, fm = gid * wgm, gsz = (nM - fm) < wgm ? (nM - fm) : wgm;
        u.pm = fm + ((wgid % nig) % gsz); u.pn = (wgid % nig) / gsz;
    }
    __host__ __device__ bool next(int i, Unit& u) const { const long L = (long)i * G + c; if (L >= nwg) return false; map((int)L, u); return true; }
    __device__ __forceinline__ void a_ready(const Unit&) const {}
    __device__ __forceinline__ void done(const Unit&) const {}
};
struct MergedOrder {
    StaticOrder S; int eM, eN, ePm0;
    __host__ __device__ bool next(int i, Unit& u) const {
        const int G = S.G, c = S.c, nfull = S.nwg / G, rem = S.nwg - nfull * G, nx = eM * eN;
        if (nfull < 1 || rem + 2 * nx > G) {
            if (S.next(i, u)) return true;
            const long L = (long)i * G + c - S.nwg; if (L >= (long)nx) return false;
            u.pm = ePm0 + (int)(L / eN); u.pn = S.nN + (int)(L % eN); return true;
        }
        if (c >= rem && c < rem + nx) {
            if (i < nfull - 1) return S.next(i, u);
            if (i > nfull - 1) return false;
            const int e = c - rem; u.pm = ePm0 + e / eN; u.pn = S.nN + e % eN; return true;
        }
        if (c >= rem + nx && c < rem + 2 * nx) {
            if (i < nfull) return S.next(i, u);
            if (i > nfull) return false;
            S.map((nfull - 1) * G + (c - nx), u); return true;
        }
        return S.next(i, u);
    }
    __device__ __forceinline__ void a_ready(const Unit&) const {}
    __device__ __forceinline__ void done(const Unit&) const {}
};

__device__ __forceinline__ unsigned cvt_pk_bf16(float lo, float hi) { unsigned r; asm volatile("v_cvt_pk_bf16_f32 %0, %1, %2" : "=v"(r) : "v"(lo), "v"(hi)); return r; }

template <class Epi, class Sched, bool ALIGN_EPI = false, bool SP2 = false>
__device__ __forceinline__ void gemm_phase(PG8_LAS unsigned char* lds, const Gemm g, const Sched& S, const Epi& E) {
    const int tid = threadIdx.x, wid = __builtin_amdgcn_readfirstlane(tid >> 6), lane = tid & 63, wr = wid >> 2, wc = wid & 3, fr = lane & 15, fq = lane >> 4;
    const int K = g.K, nt = K / BK;
    unsigned voffA[2], voffB[2];
#pragma unroll
    for (int i = 0; i < 2; ++i) { int R, C; stage_rc(tid * 16 + i * 8192, R, C); const int Rb = Epi::PERM ? ((R & ~31) + perm32(R & 31)) : R;
        voffA[i] = (unsigned)(R * K + C) * 2u; voffB[i] = (unsigned)(Rb * K + C) * 2u; }
    const size_t kstep = (size_t)(BK * 2);
    const size_t hstep = (size_t)HALF * K * 2;
    const size_t tstep = 2 * hstep;
    const unsigned ldsw = (unsigned)wid * 1024u;
    const int aoff = lds_byte(wr * 64 + fr, fq * 8), boff = lds_byte(wc * 32 + fr, fq * 8);
#define PG8_SA(b, h) (((b) * 2 + (h)) * HTB)
#define PG8_SB(b, h) ((4 + (b) * 2 + (h)) * HTB)
#define PG8_STAGE(bufoff, gbase, voff) do { _Pragma("unroll") for (int _i = 0; _i < 2; ++_i) \
        __builtin_amdgcn_global_load_lds((const unsigned*)((const char*)(gbase) + (voff)[_i]), (PG8_LAS unsigned*)(lds + (bufoff) + ldsw + _i * 8192), 16, 0, 0); } while (0)
#define PG8_LDA(dst, b, h) do { _Pragma("unroll") for (int m = 0; m < 4; ++m) _Pragma("unroll") for (int k = 0; k < 2; ++k) dst[m][k] = *(const PG8_LAS bf16x8*)(lds + PG8_SA(b, h) + aoff + m * 2048 + k * 1024); } while (0)
#define PG8_LDB(dst, b, h) do { _Pragma("unroll") for (int n = 0; n < 2; ++n) _Pragma("unroll") for (int k = 0; k < 2; ++k) dst[n][k] = *(const PG8_LAS bf16x8*)(lds + PG8_SB(b, h) + boff + n * 2048 + k * 1024); } while (0)
#define PG8_MMA(ai, bj, At, Bt) do { __builtin_amdgcn_s_setprio(1); _Pragma("unroll") for (int m = 0; m < 4; ++m) _Pragma("unroll") for (int n = 0; n < 2; ++n) _Pragma("unroll") for (int k = 0; k < 2; ++k) \
        acc[ai][bj][m][n] = __builtin_amdgcn_mfma_f32_16x16x32_bf16(Bt[n][k], At[m][k], acc[ai][bj][m][n], 0, 0, 0); __builtin_amdgcn_s_setprio(0); } while (0)
#define PG8_WAIT_V(n) asm volatile("s_waitcnt vmcnt(" #n ")" ::: "memory")
#define PG8_WAIT_L(n) asm volatile("s_waitcnt lgkmcnt(" #n ")" ::: "memory")
#define PG8_BAR __builtin_amdgcn_s_barrier()
#define PG8_SCHED __builtin_amdgcn_sched_barrier(0)
    Unit cur, nxt; int ui = 0;
    if (!S.next(0, cur)) return;
    f32x4 acc[2][2][4][2];
#pragma unroll
    for (int a = 0; a < 2; ++a)
#pragma unroll
        for (int b = 0; b < 2; ++b)
#pragma unroll
            for (int m = 0; m < 4; ++m)
#pragma unroll
                for (int n = 0; n < 2; ++n) acc[a][b][m][n] = (f32x4){0.f, 0.f, 0.f, 0.f};
    bf16x8 At[4][2], B0[2][2], B1[2][2];
    const char* cA = (const char*)g.A + (size_t)cur.pm * tstep; const char* cB = (const char*)g.Bt + (size_t)cur.pn * tstep;
    S.a_ready(cur);
    if constexpr (SP2) {
        PG8_STAGE(PG8_SB(0, 0), cB, voffB); PG8_STAGE(PG8_SB(0, 1), cB + hstep, voffB); PG8_STAGE(PG8_SA(0, 0), cA, voffA); PG8_STAGE(PG8_SA(0, 1), cA + hstep, voffA);
        if (wr == 1) PG8_BAR;
        PG8_WAIT_V(2); PG8_BAR;
        PG8_STAGE(PG8_SB(1, 0), cB + kstep, voffB); PG8_STAGE(PG8_SA(1, 0), cA + kstep, voffA); PG8_STAGE(PG8_SB(1, 1), cB + hstep + kstep, voffB);
        PG8_WAIT_V(6); PG8_BAR;
    } else {
        PG8_STAGE(PG8_SB(0, 0), cB, voffB); PG8_STAGE(PG8_SA(0, 0), cA, voffA); PG8_STAGE(PG8_SB(0, 1), cB + hstep, voffB); PG8_STAGE(PG8_SA(0, 1), cA + hstep, voffA);
        if (wr == 1) PG8_BAR;
        PG8_WAIT_V(4); PG8_BAR;
        PG8_STAGE(PG8_SB(1, 0), cB + kstep, voffB); PG8_STAGE(PG8_SA(1, 0), cA + kstep, voffA); PG8_STAGE(PG8_SB(1, 1), cB + hstep + kstep, voffB);
        PG8_WAIT_V(6); PG8_BAR;
    }
    for (;;) {
        const bool has_next = S.next(ui + 1, nxt);
        const char* nA = has_next ? (const char*)g.A + (size_t)nxt.pm * tstep : cA; const char* nB = has_next ? (const char*)g.Bt + (size_t)nxt.pn * tstep : cB;
        for (int t = 0; t < nt; t += 2) {
            const bool last = (t == nt - 2);
            const char* a1 = cA + (size_t)(t + 1) * kstep;
            const char* a2 = last ? nA : cA + (size_t)(t + 2) * kstep; const char* b2 = last ? nB : cB + (size_t)(t + 2) * kstep;
            const char* a3 = a2 + kstep; const char* b3 = b2 + kstep;
            if (last && has_next) S.a_ready(nxt);
            if constexpr (SP2) {
            PG8_LDB(B0, 0, 0); PG8_LDB(B1, 0, 1); PG8_SCHED; PG8_LDA(At, 0, 0); PG8_STAGE(PG8_SA(1, 1), a1 + hstep, voffA);
            PG8_WAIT_V(8); PG8_WAIT_L(0); PG8_BAR; PG8_MMA(0, 0, At, B0); PG8_MMA(0, 1, At, B1); PG8_BAR; PG8_SCHED;
            PG8_LDA(At, 0, 1); PG8_STAGE(PG8_SB(0, 0), b2, voffB); PG8_STAGE(PG8_SB(0, 1), b2 + hstep, voffB); PG8_STAGE(PG8_SA(0, 0), a2, voffA);
            PG8_WAIT_V(8); PG8_WAIT_L(0); PG8_BAR; PG8_MMA(1, 0, At, B0); PG8_MMA(1, 1, At, B1); PG8_BAR; PG8_SCHED;
            PG8_LDB(B0, 1, 0); PG8_LDB(B1, 1, 1); PG8_SCHED; PG8_LDA(At, 1, 0); PG8_STAGE(PG8_SA(0, 1), a2 + hstep, voffA);
            PG8_WAIT_V(8); PG8_WAIT_L(0); PG8_BAR; PG8_MMA(0, 0, At, B0); PG8_MMA(0, 1, At, B1); PG8_BAR; PG8_SCHED;
            PG8_LDA(At, 1, 1); PG8_STAGE(PG8_SB(1, 0), b3, voffB); PG8_STAGE(PG8_SB(1, 1), b3 + hstep, voffB); PG8_STAGE(PG8_SA(1, 0), a3, voffA);
            PG8_WAIT_V(8); PG8_WAIT_L(0); PG8_BAR; PG8_MMA(1, 0, At, B0); PG8_MMA(1, 1, At, B1); PG8_BAR; PG8_SCHED;
            } else {
            PG8_LDB(B0, 0, 0); PG8_SCHED; PG8_LDA(At, 0, 0); PG8_STAGE(PG8_SA(1, 1), a1 + hstep, voffA);
            PG8_WAIT_L(8); PG8_BAR; PG8_WAIT_L(0); PG8_MMA(0, 0, At, B0); PG8_BAR; PG8_SCHED;
            PG8_LDB(B1, 0, 1); PG8_STAGE(PG8_SB(0, 0), b2, voffB);
            PG8_BAR; PG8_WAIT_L(0); PG8_MMA(0, 1, At, B1); PG8_BAR;
            PG8_LDA(At, 0, 1); PG8_STAGE(PG8_SA(0, 0), a2, voffA);
            PG8_BAR; PG8_WAIT_L(0); PG8_MMA(1, 0, At, B0); PG8_BAR; PG8_SCHED;
            PG8_STAGE(PG8_SB(0, 1), b2 + hstep, voffB);
            PG8_WAIT_V(6); PG8_BAR; PG8_MMA(1, 1, At, B1); PG8_BAR;
            PG8_LDB(B0, 1, 0); PG8_SCHED; PG8_LDA(At, 1, 0); PG8_STAGE(PG8_SA(0, 1), a2 + hstep, voffA);
            PG8_WAIT_L(8); PG8_BAR; PG8_WAIT_L(0); PG8_MMA(0, 0, At, B0); PG8_BAR; PG8_SCHED;
            PG8_LDB(B1, 1, 1); PG8_STAGE(PG8_SB(1, 0), b3, voffB);
            PG8_BAR; PG8_WAIT_L(0); PG8_MMA(0, 1, At, B1); PG8_BAR;
            PG8_LDA(At, 1, 1); PG8_STAGE(PG8_SA(1, 0), a3, voffA);
            PG8_BAR; PG8_WAIT_L(0); PG8_MMA(1, 0, At, B0); PG8_BAR; PG8_SCHED;
            PG8_STAGE(PG8_SB(1, 1), b3 + hstep, voffB);
            PG8_WAIT_V(6); PG8_BAR; PG8_MMA(1, 1, At, B1); PG8_BAR;
            }
        }
        if constexpr (ALIGN_EPI) { if (wr == 0) PG8_BAR; }
        E(acc, cur, wr, wc, fr, fq); S.done(cur);
        if (!has_next) break;
#pragma unroll
        for (int a = 0; a < 2; ++a)
#pragma unroll
            for (int b = 0; b < 2; ++b)
#pragma unroll
                for (int m = 0; m < 4; ++m)
#pragma unroll
                    for (int n = 0; n < 2; ++n) acc[a][b][m][n] = (f32x4){0.f, 0.f, 0.f, 0.f};
        cur = nxt; cA = nA; cB = nB; ++ui;
        if constexpr (ALIGN_EPI) { if (wr == 1) PG8_BAR; }
    }
    PG8_WAIT_V(0);
    if constexpr (!ALIGN_EPI) { if (wr == 0) PG8_BAR; }
    PG8_BAR;
#undef PG8_SA
#undef PG8_SB
#undef PG8_STAGE
#undef PG8_LDA
#undef PG8_LDB
#undef PG8_MMA
#undef PG8_WAIT_V
#undef PG8_WAIT_L
#undef PG8_BAR
#undef PG8_SCHED
}
}

typedef unsigned short bf16_t;
constexpr int D_MODEL = 1024, BATCH = 16, SEQ = 2048, MEM_LEN = 256, HD = 64, CHUNK = 128;
constexpr int M_TOK = BATCH * SEQ, M_MEM = BATCH * MEM_LEN;
constexpr int A_WIDTH = 512, IN_WIDTH = 2816, MKV_W = 512;
constexpr int C_U = 0, C_V = 512, C_SQ = 1024, C_SK = 1280, C_SV = 1408, C_MQ = 1536, C_Z = 1792;
constexpr size_t MT = (size_t)BATCH * SEQ;
constexpr size_t PU_OFF = 0, PV_OFF = PU_OFF + 4 * MT * 128, PQ_OFF = PV_OFF + 4 * MT * 128, PK_OFF = PQ_OFF + 4 * MT * 64, PVV_OFF = PK_OFF + 2 * MT * 64, PMQ_OFF = PVV_OFF + 2 * MT * 64, PZ_OFF = PMQ_OFF + 4 * MT * 64;
static_assert(PZ_OFF + 16 * MT * 64 == MT * 2816, "blocked PROJ layout covers exactly IN_WIDTH columns");
constexpr size_t MV_OFF = (size_t)BATCH * 4 * MEM_LEN * 64;
constexpr float EPS = 1e-6f;
constexpr float LOG2E = 1.4426950408889634f;
constexpr float QSCALE = 0.125f * LOG2E;
constexpr int NWAVES = 8;

constexpr size_t MiB = 1u << 20;
constexpr size_t WS_CTL = 0, CTL_ZERO_BYTES = 64 * 1024;
constexpr size_t WS_WIN = 2 * MiB;
constexpr size_t WS_WOUT = 10 * MiB;
constexpr size_t WS_WSP = 12 * MiB;
constexpr size_t WS_SSP = 13 * MiB;
constexpr size_t WS_XN = 16 * MiB;
constexpr size_t WS_PROJ = 96 * MiB;
constexpr size_t WS_MKV = 272 * MiB;
constexpr size_t WS_Y = 280 * MiB;
constexpr size_t WS_O = 344 * MiB;
constexpr size_t WS_END = 408 * MiB;
constexpr int CW_BAR = 1024;

constexpr int RING_BYTES = 131072, LDSCTL_OFF = 138240, MISC_OFF = LDSCTL_OFF + 320, LDS_BYTES = 147456;

#define GAS __attribute__((address_space(1)))
#define LAS __attribute__((address_space(3)))
typedef unsigned v4u __attribute__((ext_vector_type(4)));
typedef unsigned v2u __attribute__((ext_vector_type(2)));
typedef float f32x4 __attribute__((ext_vector_type(4)));
#define LDS_WAIT() asm volatile("s_waitcnt lgkmcnt(0)" ::: "memory")
#define VM_WAIT() asm volatile("s_waitcnt vmcnt(0)" ::: "memory")
__device__ __forceinline__ float bf2f(bf16_t v) { return __builtin_bit_cast(float, (unsigned)v << 16); }
__device__ __forceinline__ unsigned f2bf(float f) { unsigned u = __builtin_bit_cast(unsigned, f); return (u + 0x7fffu + ((u >> 16) & 1u)) >> 16; }
__device__ __forceinline__ unsigned pk2(float lo, float hi) { return f2bf(lo) | (f2bf(hi) << 16); }
__device__ __forceinline__ float bflo(unsigned w) { return __builtin_bit_cast(float, w << 16); }
__device__ __forceinline__ float bfhi(unsigned w) { return __builtin_bit_cast(float, w & 0xffff0000u); }
__device__ __forceinline__ float fast_sigmoid_mul(float x, float t) { return x * __builtin_amdgcn_rcpf(1.f + __builtin_amdgcn_exp2f(-t * LOG2E)); }
__device__ __forceinline__ float gelu_tanh(float x) { return fast_sigmoid_mul(x, 1.5957691216057308f * (x + 0.044715f * x * x * x)); }
__device__ __forceinline__ float silu(float x) { return fast_sigmoid_mul(x, x); }
typedef float f32x2 __attribute__((ext_vector_type(2)));
__device__ __forceinline__ f32x2 sigmoid_mul_pk(f32x2 x, f32x2 tneg) {
    f32x2 e; e.x = __builtin_amdgcn_exp2f(tneg.x); e.y = __builtin_amdgcn_exp2f(tneg.y);
    const f32x2 d = e + 1.0f; f32x2 r; r.x = __builtin_amdgcn_rcpf(d.x); r.y = __builtin_amdgcn_rcpf(d.y);
    return x * r;
}
__device__ __forceinline__ f32x2 gelu_tanh_pk(f32x2 x) { const f32x2 x2 = x * x; const f32x2 q = x2 * (-0.044715f * 1.5957691216057308f * LOG2E) + (-1.5957691216057308f * LOG2E); return sigmoid_mul_pk(x, x * q); }
__device__ __forceinline__ f32x2 silu_pk(f32x2 x) { return sigmoid_mul_pk(x, x * (-LOG2E)); }
__device__ __forceinline__ float wave_sum(float v) {
#pragma unroll
    for (int o = 1; o < 64; o <<= 1) v += __shfl_xor(v, o);
    return v;
}

#define XB_TMO      128
#define XB_XCNT(j)  (256  + 64 * (j))
#define XB_XSUB(j)  (1280 + 64 * (j))
#define XB_XGEN(j)  (2304 + 64 * (j))
#define XB_TOP      3328
#define XB_TOPGEN   3392
#define XCD_BAR_WORDS 3456
#define XB_SPIN_CAP (1u << 18)
__device__ __forceinline__ unsigned xb_ld(unsigned* p)              { return __hip_atomic_load(p, __ATOMIC_RELAXED, __HIP_MEMORY_SCOPE_AGENT); }
__device__ __forceinline__ unsigned xb_add(unsigned* p, unsigned v) { return __hip_atomic_fetch_add(p, v, __ATOMIC_RELAXED, __HIP_MEMORY_SCOPE_AGENT); }
__device__ __forceinline__ unsigned xb_xcc_id() { return (unsigned)__builtin_amdgcn_s_getreg((3 << 11) | 20) & 0xFu; }
#define XB_SPIN(cond, bar) do { unsigned _sp = 0; while (cond) { __builtin_amdgcn_s_sleep(1); \
    if ((++_sp & 255u) == 0u) { if (xb_ld(&(bar)[XB_TMO])) break; if (_sp > XB_SPIN_CAP) { atomicAdd(&(bar)[XB_TMO], 1u); break; } } } } while (0)
struct XcdBarrier { unsigned* bar; unsigned x; volatile LAS unsigned* st; unsigned n; };
__device__ __forceinline__ XcdBarrier xcd_barrier_post(unsigned* bar, volatile LAS unsigned* st, unsigned n) {
    XcdBarrier b; b.bar = bar; b.x = xb_xcc_id(); b.st = st; b.n = n;
    if (threadIdx.x == 0) (void)xb_add(&bar[XB_XCNT(b.x)], 1u);
    return b;
}
__device__ __forceinline__ void xcd_barrier_complete(unsigned* bar, unsigned x, unsigned G, unsigned& nloc, unsigned& nx) {
    unsigned sum, cnt, mine, sp = 0u;
    for (;;) {
        sum = 0u; cnt = 0u; mine = 0u;
#pragma unroll
        for (unsigned j = 0; j < 16; ++j) { const unsigned c = xb_ld(&bar[XB_XCNT(j)]); sum += c; cnt += (c > 0u) ? 1u : 0u; mine = (j == x) ? c : mine; }
        if (sum == G) break;
        __builtin_amdgcn_s_sleep(1);
        if ((++sp & 255u) == 0u) { if (xb_ld(&bar[XB_TMO])) break; if (sp > XB_SPIN_CAP) { atomicAdd(&bar[XB_TMO], 1u); break; } }
    }
    nloc = mine > 0u ? mine : 1u; nx = cnt > 0u ? cnt : 1u;
}
__device__ __forceinline__ void xcd_barrier(const XcdBarrier& b) {
    asm volatile("s_waitcnt vmcnt(0)" ::: "memory");
    __syncthreads();
    if (threadIdx.x == 0) {
        unsigned* bar = b.bar;
        __builtin_amdgcn_s_waitcnt(0);
        unsigned nloc = b.st[0], nx = b.st[1];
        if (nloc == 0u) { xcd_barrier_complete(bar, b.x, b.n, nloc, nx); b.st[0] = nloc; b.st[1] = nx; }
        const unsigned old = xb_add(&bar[XB_XSUB(b.x)], 1u);
        const unsigned gen = old / nloc;
        if (old + 1u == (gen + 1u) * nloc) {
            __builtin_amdgcn_fence(__ATOMIC_RELEASE, "agent");
            asm volatile("s_waitcnt vmcnt(0)" ::: "memory");
            const unsigned og = xb_add(&bar[XB_TOP], 1u);
            const unsigned tg = og / nx;
            if (og + 1u == (tg + 1u) * nx) xb_add(&bar[XB_TOPGEN], 1u);
            else XB_SPIN(xb_ld(&bar[XB_TOPGEN]) == tg, bar);
            __builtin_amdgcn_fence(__ATOMIC_ACQUIRE, "agent");
            xb_add(&bar[XB_XGEN(b.x)], 1u);
            asm volatile("s_waitcnt vmcnt(0)" ::: "memory");
        } else {
            XB_SPIN(xb_ld(&bar[XB_XGEN(b.x)]) == gen, bar);
            __builtin_amdgcn_fence(__ATOMIC_ACQUIRE, "agent");
            asm volatile("s_waitcnt vmcnt(0)" ::: "memory");
        }
    }
    __syncthreads();
}

struct Args {
    const float *x, *mem, *g_pre, *g_post, *g_mem, *w_in, *w_mkv, *vg, *vb, *wsp, *bsp, *sinks, *relb, *w_out;
    float* out; unsigned char* ws;
};

__device__ __forceinline__ void p0_transpose_item(const float* W, int K, int N, bf16_t* WT, int row_off, LAS float* scr, int item, int lane) {
    const int nblk = N / 32, kb = item / nblk, nb = item % nblk, k0 = 64 * kb, n0 = 32 * nb;
    float wv[32];
#pragma unroll
    for (int i = 0; i < 32; ++i) wv[i] = __builtin_nontemporal_load(&W[(size_t)(k0 + 2 * i + (lane >> 5)) * N + n0 + (lane & 31)]);
#pragma unroll
    for (int i = 0; i < 32; ++i) scr[(2 * i + (lane >> 5)) * 33 + (lane & 31)] = wv[i];
    LDS_WAIT(); asm volatile("" ::: "memory");
    const int c = lane & 7;
#pragma unroll
    for (int j = 0; j < 4; ++j) { const int n = (lane >> 3) + 8 * j; const LAS float* s = scr + (8 * c) * 33 + n;
        v4u o; o.x = pk2(s[0 * 33], s[1 * 33]); o.y = pk2(s[2 * 33], s[3 * 33]); o.z = pk2(s[4 * 33], s[5 * 33]); o.w = pk2(s[6 * 33], s[7 * 33]);
        *(GAS v4u*)(WT + (size_t)(row_off + n0 + n) * K + k0 + 8 * c) = o; }
    LDS_WAIT(); asm volatile("" ::: "memory");
}
template <int NB> __device__ __forceinline__ void rms_rows_to_bf16(const float* src, const float* g, bf16_t* dst, int m0, int m1, int step, int lane) {
    if (m0 >= m1) return;
    const int mlast = m0 + ((m1 - 1 - m0) / step) * step;
    const GAS f32x4* gr = (const GAS f32x4*)g + lane;
    f32x4 gg[4];
#pragma unroll
    for (int j = 0; j < 4; ++j) gg[j] = gr[64 * j];
    f32x4 v[NB][4], nx[NB][4];
#pragma unroll
    for (int i = 0; i < NB; ++i) { const int mr = m0 + i * step < mlast ? m0 + i * step : mlast; const GAS f32x4* xr = (const GAS f32x4*)(src + (size_t)mr * D_MODEL) + lane;
#pragma unroll
        for (int j = 0; j < 4; ++j) v[i][j] = __builtin_nontemporal_load(&xr[64 * j]); }
    for (int m = m0; m < m1; m += NB * step) {
#pragma unroll
        for (int i = 0; i < NB; ++i) { const int mn = m + (NB + i) * step, mr = mn < mlast ? mn : mlast; const GAS f32x4* xr = (const GAS f32x4*)(src + (size_t)mr * D_MODEL) + lane;
#pragma unroll
            for (int j = 0; j < 4; ++j) nx[i][j] = __builtin_nontemporal_load(&xr[64 * j]); }
#pragma unroll
        for (int i = 0; i < NB; ++i) {
            const int mi = m + i * step;
            float s = 0.f;
#pragma unroll
            for (int j = 0; j < 4; ++j) s += (v[i][j].x * v[i][j].x + v[i][j].y * v[i][j].y) + (v[i][j].z * v[i][j].z + v[i][j].w * v[i][j].w);
            const float r = rsqrtf(wave_sum(s) * (1.f / D_MODEL) + EPS);
            if (mi < m1) {
                GAS v2u* o8 = (GAS v2u*)(dst + (size_t)mi * D_MODEL) + lane;
#pragma unroll
                for (int j = 0; j < 4; ++j) { v2u w; w.x = pk2(v[i][j].x * r * gg[j].x, v[i][j].y * r * gg[j].y); w.y = pk2(v[i][j].z * r * gg[j].z, v[i][j].w * r * gg[j].w); o8[64 * j] = w; }
            }
        }
#pragma unroll
        for (int i = 0; i < NB; ++i)
#pragma unroll
            for (int j = 0; j < 4; ++j) v[i][j] = nx[i][j];
    }
}

struct EpiProj {
    static constexpr bool PERM = true;
    bf16_t* PROJ; bf16_t* MKV; int pm_base, mem_pm0, mem_b0;
    template <int ACT> __device__ __forceinline__ void tile(const pg8::f32x4 (&acc)[2][2][4][2], bf16_t* b0, bf16_t* b1, int pitch) const {
#pragma unroll
        for (int ai = 0; ai < 2; ++ai)
#pragma unroll
            for (int m = 0; m < 4; ++m) { const size_t ro = (size_t)(ai * 128 + m * 16) * pitch;
#pragma unroll
                for (int bj = 0; bj < 2; ++bj) { f32x2 p[4];
#pragma unroll
                    for (int e = 0; e < 2; ++e) { p[e] = (f32x2){acc[ai][bj][m][0][2 * e], acc[ai][bj][m][0][2 * e + 1]}; p[2 + e] = (f32x2){acc[ai][bj][m][1][2 * e], acc[ai][bj][m][1][2 * e + 1]}; }
#pragma unroll
                    for (int e = 0; e < 4; ++e) { if (ACT == 1) p[e] = gelu_tanh_pk(p[e]); else if (ACT == 2) p[e] = p[e] * QSCALE; else if (ACT == 3) p[e] = silu_pk(p[e]); }
                    pg8::u32x4 w; w.x = pg8::cvt_pk_bf16(p[0].x, p[0].y); w.y = pg8::cvt_pk_bf16(p[1].x, p[1].y); w.z = pg8::cvt_pk_bf16(p[2].x, p[2].y); w.w = pg8::cvt_pk_bf16(p[3].x, p[3].y);
                    __builtin_nontemporal_store(w, (pg8::u32x4*)((bj ? b1 : b0) + ro)); } }
    }
    __device__ __forceinline__ void operator()(const pg8::f32x4 (&acc)[2][2][4][2], const pg8::Unit& u, int wr, int wc, int fr, int fq) const {
        const int c128 = wc * 32 + 8 * fq, c64 = (wc & 1) * 32 + 8 * fq, k64 = wc >> 1;
        if (u.pn < 11) {
            const size_t row = (size_t)(pm_base + u.pm) * 256 + wr * 64 + fr;
            if (u.pn < 4) {
                bf16_t* base = PROJ + (u.pn < 2 ? PU_OFF : PV_OFF) + (size_t)(2 * (u.pn & 1)) * MT * 128 + row * 128 + c128;
                tile<1>(acc, base, base + MT * 128, 128);
            } else if (u.pn == 4 || u.pn == 6) {
                bf16_t* base = PROJ + (u.pn == 4 ? PQ_OFF : PMQ_OFF) + (size_t)k64 * MT * 64 + row * 64 + c64;
                tile<2>(acc, base, base + 2 * MT * 64, 64);
            } else if (u.pn == 5) {
                bf16_t* base = PROJ + PK_OFF + (size_t)k64 * MT * 64 + row * 64 + c64;
                tile<0>(acc, base, base + (PVV_OFF - PK_OFF), 64);
            } else {
                bf16_t* base = PROJ + PZ_OFF + (size_t)(4 * (u.pn - 7) + k64) * MT * 64 + row * 64 + c64;
                tile<3>(acc, base, base + 2 * MT * 64, 64);
            }
        } else {
            const int b = mem_b0 + (u.pm - mem_pm0); const size_t key = (size_t)wr * 64 + fr;
            bf16_t* base = MKV + (u.pn - 11) * MV_OFF + ((size_t)(b * 4 + k64) * MEM_LEN + key) * 64 + c64;
            tile<0>(acc, base, base + (size_t)2 * MEM_LEN * 64, 64);
        }
    }
};
struct EpiOut {
    static constexpr bool PERM = true;
    bf16_t* O; float* SSP; int pm_base;
    __device__ __forceinline__ void operator()(const pg8::f32x4 (&acc)[2][2][4][2], const pg8::Unit& u, int wr, int wc, int fr, int fq) const {
        const int row0 = (pm_base + u.pm) * 256 + wr * 64 + fr, col0 = u.pn * 256 + wc * 32 + 8 * fq;
#pragma unroll
        for (int ai = 0; ai < 2; ++ai)
#pragma unroll
            for (int m = 0; m < 4; ++m) { const int row = row0 + ai * 128 + m * 16; bf16_t* rowp = O + (size_t)row * D_MODEL + col0; float ss = 0.f;
#pragma unroll
                for (int bj = 0; bj < 2; ++bj) { const pg8::f32x4 v0 = acc[ai][bj][m][0], v1 = acc[ai][bj][m][1];
                    ss += (v0[0] * v0[0] + v0[1] * v0[1]) + (v0[2] * v0[2] + v0[3] * v0[3]) + (v1[0] * v1[0] + v1[1] * v1[1]) + (v1[2] * v1[2] + v1[3] * v1[3]);
                    pg8::u32x4 w; w.x = pg8::cvt_pk_bf16(v0[0], v0[1]); w.y = pg8::cvt_pk_bf16(v0[2], v0[3]); w.z = pg8::cvt_pk_bf16(v1[0], v1[1]); w.w = pg8::cvt_pk_bf16(v1[2], v1[3]);
                    *(pg8::u32x4*)(rowp + bj * 128) = w; }
                ss += __shfl_xor(ss, 16); ss += __shfl_xor(ss, 32);
                if (fq == 0) SSP[(size_t)row * 16 + u.pn * 4 + wc] = ss; }
    }
};

__device__ __forceinline__ int t5_bucket(int n) {
    if (n < 16) return n;
    int l = 16 + (int)(__logf((float)n * (1.f / 16.f)) * (16.f / 2.0794415416798357f));
    return l < 31 ? l : 31;
}

namespace mix {
typedef short bf16x8 __attribute__((ext_vector_type(8)));
typedef short s16x4 __attribute__((ext_vector_type(4)));
typedef float f32x16 __attribute__((ext_vector_type(16)));
typedef unsigned u32x4 __attribute__((ext_vector_type(4)));
typedef float f32x2_t __attribute__((ext_vector_type(2))); typedef __bf16 bf16x2_t __attribute__((ext_vector_type(2)));
constexpr int L1_OFF = 33280, STG_OFF = 66560, STG_WAVE = 8192, BIAS_OFF = 132096  , WSF_OFF = 136192, BSP_OFF = 138752  , VGB_OFF = 140800  ;
constexpr int SWA_VSTR = 256 * 64 + 64;
constexpr int X_KH = 16384, X_VH = 16512, X_VSTR = 128 * 64 + 64;
constexpr int G_GRP = 16640, G_CSTR = 64 * 64 + 64;

__device__ __forceinline__ int crow(int r, int hi) { return (r & 3) + 8 * (r >> 2) + 4 * hi; }
__device__ __forceinline__ s16x4 vtr(const LAS unsigned char* p) { return __builtin_bit_cast(s16x4, __builtin_amdgcn_ds_read_tr16_b64_v4i16((LAS s16x4*)p)); }
__device__ __forceinline__ unsigned cvtpk(float lo, float hi) { f32x2_t v = {lo, hi}; bf16x2_t b = __builtin_convertvector(v, bf16x2_t); return __builtin_bit_cast(unsigned, b); }
__device__ __forceinline__ u32x4 mul8(u32x4 a, u32x4 b) { u32x4 r;
#pragma unroll
    for (int e = 0; e < 4; ++e) r[e] = cvtpk(bflo(a[e]) * bflo(b[e]), bfhi(a[e]) * bfhi(b[e]));
    return r; }
__device__ __forceinline__ u32x4 mul8x3(u32x4 a, u32x4 b, u32x4 c) { u32x4 r;
#pragma unroll
    for (int e = 0; e < 4; ++e) r[e] = cvtpk(bflo(a[e]) * bflo(b[e]) * bflo(c[e]), bfhi(a[e]) * bfhi(b[e]) * bfhi(c[e]));
    return r; }

__device__ __forceinline__ f32x16 qk_block(const LAS unsigned char* Kt, int key0, const bf16x8 (&qf)[4], int r32, int hi, f32x16 s) {
    const int key = key0 + r32, sw = (key >> 1) & 7; const LAS unsigned char* kr = Kt + key * 128;
#pragma unroll
    for (int d0 = 0; d0 < 4; ++d0) { const bf16x8 kf = *(const LAS bf16x8*)(kr + (((2 * d0 + hi) ^ sw) << 4)); s = __builtin_amdgcn_mfma_f32_32x32x16_bf16(kf, qf[d0], s, 0, 0, 0); }
    return s;
}
__device__ __forceinline__ void pv_block(f32x16 (&o)[2], const f32x16& p, const LAS unsigned char* Vt, int vstr, int key0, int lane) {
    const LAS unsigned char* vb = Vt + (key0 + 4 * (lane >> 5) + ((lane >> 2) & 3)) * 64 + ((lane >> 4) & 1) * 32 + (lane & 3) * 8;
#pragma unroll
    for (int s = 0; s < 2; ++s) {
        u32x4 pw; pw[0] = cvtpk(p[8 * s + 0], p[8 * s + 1]); pw[1] = cvtpk(p[8 * s + 2], p[8 * s + 3]); pw[2] = cvtpk(p[8 * s + 4], p[8 * s + 5]); pw[3] = cvtpk(p[8 * s + 6], p[8 * s + 7]);
        const bf16x8 pa = __builtin_bit_cast(bf16x8, pw);
#pragma unroll
        for (int dblk = 0; dblk < 2; ++dblk) {
            const s16x4 lo = vtr(vb + dblk * vstr + s * 1024), hi4 = vtr(vb + dblk * vstr + s * 1024 + 512);
            const bf16x8 vf = {lo[0], lo[1], lo[2], lo[3], hi4[0], hi4[1], hi4[2], hi4[3]};
            o[dblk] = __builtin_amdgcn_mfma_f32_32x32x16_bf16(pa, vf, o[dblk], 0, 0, 0);
        }
    }
}
struct TileSrc { const bf16_t* p; long s_hi; };
__device__ __forceinline__ void load_half(u32x4 (&r)[4], const TileSrc t, int tid) {
    const bf16_t* p = t.p + (long)tid * 8;
#pragma unroll
    for (int it = 0; it < 4; ++it) r[it] = *(const u32x4*)(p + (it >> 1) * t.s_hi + (it & 1) * 4096);
}
__device__ __forceinline__ void write_k(const u32x4 (&r)[4], LAS unsigned char* L, bool zero_lo, int tid) {
    const int ch = tid & 7, kl = tid >> 3; LAS unsigned char* d = L + kl * 128 + ((ch ^ ((kl >> 1) & 7)) << 4);
    const unsigned keep = zero_lo ? 0u : 0xffffffffu;
#pragma unroll
    for (int it = 0; it < 4; ++it) { u32x4 v = r[it]; if (it < 2) { v[0] &= keep; v[1] &= keep; v[2] &= keep; v[3] &= keep; } *(LAS u32x4*)(d + it * 8192) = v; }
}
__device__ __forceinline__ void write_v_swa(const u32x4 (&r)[4], LAS unsigned char* L, bool zero_lo, int tid) {
    const int ch = tid & 7, kl = tid >> 3; LAS unsigned char* d = L + (ch >> 2) * SWA_VSTR + kl * 64 + (ch & 3) * 16;
    const unsigned keep = zero_lo ? 0u : 0xffffffffu;
#pragma unroll
    for (int it = 0; it < 4; ++it) { u32x4 v = r[it]; if (it < 2) { v[0] &= keep; v[1] &= keep; v[2] &= keep; v[3] &= keep; } *(LAS u32x4*)(d + it * 4096) = v; }
}
__device__ __forceinline__ void write_v_x(const u32x4 (&r)[4], LAS unsigned char* L, int tid) {
    const int ch = tid & 7, kl = tid >> 3; LAS unsigned char* d = L + (ch >> 2) * X_VSTR + kl * 64 + (ch & 3) * 16;
#pragma unroll
    for (int it = 0; it < 4; ++it) *(LAS u32x4*)(d + (it >> 1) * X_VH + (it & 1) * 4096) = r[it];
}
__device__ __forceinline__ float row16_sum(float v) {
    v += __shfl_xor(v, 1); v += __shfl_xor(v, 2); v += __shfl_xor(v, 4); v += __shfl_xor(v, 8);
    return v;
}
__device__ __forceinline__ void write_g(const u32x4 (&r)[4], LAS unsigned char* L, const LAS float* vgb, int gp, int tid) {
    const int ch = tid & 15;
#pragma unroll
    for (int it = 0; it < 4; ++it) { const int gl = it >> 1, srow = (it & 1) * 32 + (tid >> 4), g = 2 * gp + gl;
        float v[8];
#pragma unroll
        for (int e = 0; e < 4; ++e) { v[2 * e] = bflo(r[it][e]); v[2 * e + 1] = bfhi(r[it][e]); }
        const float mu = row16_sum(((v[0] + v[1]) + (v[2] + v[3])) + ((v[4] + v[5]) + (v[6] + v[7]))) * (1.f / 128.f); float sq = 0.f;
#pragma unroll
        for (int e = 0; e < 8; ++e) { v[e] -= mu; sq += v[e] * v[e]; }
        const float rs = rsqrtf(row16_sum(sq) * (1.f / 128.f) + EPS);
        const LAS f32x4* gq = (const LAS f32x4*)(vgb + g * 128 + ch * 8); const LAS f32x4* bq = (const LAS f32x4*)(vgb + 512 + g * 128 + ch * 8);
        const f32x4 g0 = gq[0], g1 = gq[1], b0 = bq[0], b1 = bq[1];
        u32x4 w;
        w[0] = cvtpk(v[0] * rs * g0[0] + b0[0], v[1] * rs * g0[1] + b0[1]); w[1] = cvtpk(v[2] * rs * g0[2] + b0[2], v[3] * rs * g0[3] + b0[3]);
        w[2] = cvtpk(v[4] * rs * g1[0] + b1[0], v[5] * rs * g1[1] + b1[1]); w[3] = cvtpk(v[6] * rs * g1[2] + b1[2], v[7] * rs * g1[3] + b1[3]);
        *(LAS u32x4*)(L + gl * G_GRP + (ch >> 2) * G_CSTR + srow * 64 + (ch & 3) * 16) = w; }
}
__device__ __forceinline__ void attn_out(const f32x16 (&o)[2], float rinv_q, LAS unsigned char* stg, LAS float* wsf, const u32x4 (&zv)[4], bf16_t* yrow0, int lane) {
    const int r32 = lane & 31, hi = lane >> 5;
    if (hi == 0) wsf[r32] = rinv_q;
    LDS_WAIT();
    LAS bf16_t* st = (LAS bf16_t*)stg;
#pragma unroll
    for (int r = 0; r < 16; ++r) { const int q = crow(r, hi); const float ri = wsf[q];
        st[q * 64 + r32] = (bf16_t)f2bf(o[0][r] * ri); st[q * 64 + 32 + r32] = (bf16_t)f2bf(o[1][r] * ri); }
    LDS_WAIT();
#pragma unroll
    for (int i = 0; i < 4; ++i) { const int row = i * 8 + (lane >> 3), ch = lane & 7;
        const u32x4 v = *(const LAS u32x4*)(stg + row * 128 + ch * 16);
        *(u32x4*)(yrow0 + (size_t)row * D_MODEL + ch * 8) = mul8(v, zv[i]); }
    LDS_WAIT();
}
__device__ __forceinline__ void load_z4(u32x4 (&zv)[4], const bf16_t* zrow0, int lane) {
#pragma unroll
    for (int i = 0; i < 4; ++i) zv[i] = __builtin_nontemporal_load((const u32x4*)(zrow0 + (size_t)(i * 8 + (lane >> 3)) * 64 + (lane & 7) * 8));
}
__device__ __forceinline__ void load_q4(bf16x8 (&q)[4], const bf16_t* qp) {
#pragma unroll
    for (int d0 = 0; d0 < 4; ++d0) q[d0] = *(const bf16x8*)(qp + 16 * d0);
}

__device__ __forceinline__ void mix_unit(int unit, LAS unsigned char* lds, const bf16_t* __restrict__ PROJ, const bf16_t* __restrict__ MKV, const bf16_t* __restrict__ WSP, bf16_t* __restrict__ Y, int tid, int wave) {
    const int b = unit >> 4, n = unit & 15, rb = wave & 3, wh = wave >> 2;
    const size_t row0 = (size_t)b * SEQ + (size_t)n * CHUNK;
    const size_t wrow0 = row0 + 32 * rb;
    LAS unsigned char* const L0 = lds; LAS unsigned char* const L1 = lds + L1_OFF;
    LAS unsigned char* stg = lds + STG_OFF + wave * STG_WAVE;
    LAS float* wsf = (LAS float*)(lds + WSF_OFF) + wave * 64;
    const LAS float* btab = (const LAS float*)(lds + BIAS_OFF);
    const LAS float* bstab = (const LAS float*)(lds + BSP_OFF);
    const LAS float* vgb = (const LAS float*)(lds + VGB_OFF);
    const int tid_in = tid;
    const bool first = (n == 0);
#define MIX_BAR() asm volatile("s_waitcnt lgkmcnt(0)\n\ts_barrier" ::: "memory")
#define MIX_LANES() int tid = tid_in; asm volatile("" : "+v"(tid)); const int lane = tid & 63, r32 = lane & 31, hi = lane >> 5; const size_t qoff = (wrow0 + r32) * 64 + 8 * hi;
    auto tile_src = [&](int j) -> TileSrc {
        TileSrc t; j = j > 15 ? 15 : j;
        if (j < 4) { t.p = PROJ + ((j & 1) ? PVV_OFF : PK_OFF) + (size_t)(j >> 1) * MT * 64 + ((long)row0 - 128) * 64; t.s_hi = 8192; }
        else if (j < 12) { const int x = j - 4, st = x >> 1; t.p = MKV + ((x & 1) ? MV_OFF : 0) + ((size_t)(b * 4 + 2 * (st >> 1)) * MEM_LEN + (st & 1) * 128) * 64; t.s_hi = (long)MEM_LEN * 64; }
        else { const int y = j - 12; t.p = PROJ + PV_OFF + (size_t)(2 * (y >> 1)) * MT * 128 + (row0 + (y & 1) * 64) * 128; t.s_hi = (long)MT * 128; }
        return t; };
    u32x4 R0[4], R1[4]; bf16x8 qf[4];
    { MIX_LANES();
      load_half(R0, tile_src(0), tid); load_q4(qf, PROJ + PQ_OFF + (size_t)wh * MT * 64 + qoff);
      MIX_BAR();
      write_k(R0, L0, first, tid);
      load_half(R1, tile_src(1), tid); load_half(R0, tile_src(2), tid); }

#pragma unroll 1
    for (int kvh = 0; kvh < 2; ++kvh) {
        const int h = 2 * kvh + wh, j = 2 * kvh;
        f32x16 s[5]; float rinv; u32x4 zv[4];
        { MIX_LANES(); (void)qoff;
          MIX_BAR();
          write_v_swa(R1, L1, first, tid);
          load_z4(zv, PROJ + PZ_OFF + (size_t)(8 + h) * MT * 64 + wrow0 * 64, lane);
          load_half(R1, tile_src(j + 3), tid);
#pragma unroll
          for (int t = 0; t < 5; ++t) {
              const LAS float* tb = btab + ((first && rb + t < 4) ? 4 : h) * 192 + (31 - r32 + 4 * hi);
#pragma unroll
              for (int r = 0; r < 16; ++r) s[t][r] = tb[32 * t + (r & 3) + 8 * (r >> 2)];
          }
#pragma unroll
          for (int t = 0; t < 5; ++t) s[t] = qk_block(L0, 32 * (rb + t), qf, r32, hi, s[t]);
          const float sink2 = btab[5 * 192 + h]; float m = sink2;
#pragma unroll
          for (int t = 0; t < 5; ++t)
#pragma unroll
              for (int r = 0; r < 16; ++r) m = fmaxf(m, s[t][r]);
          m = fmaxf(m, __shfl_xor(m, 32));
          float l = 0.f;
#pragma unroll
          for (int t = 0; t < 5; ++t)
#pragma unroll
              for (int r = 0; r < 16; ++r) { const float p = __builtin_amdgcn_exp2f(s[t][r] - m); s[t][r] = p; l += p; }
          l += __shfl_xor(l, 32);
          rinv = __builtin_amdgcn_rcpf(l + __builtin_amdgcn_exp2f(sink2 - m)); }
        { MIX_LANES();
          MIX_BAR();
          write_k(R0, L0, kvh == 0 && first, tid);
          load_q4(qf, PROJ + (kvh == 0 ? PQ_OFF + (size_t)(2 + wh) * MT * 64 : PMQ_OFF + (size_t)wh * MT * 64) + qoff);
          load_half(R0, tile_src(j + 4), tid);
          f32x16 o[2] = {};
#pragma unroll
          for (int t = 0; t < 5; ++t) pv_block(o, s[t], L1, SWA_VSTR, 32 * (rb + t), lane);
          attn_out(o, rinv, stg, wsf, zv, Y + wrow0 * D_MODEL + 512 + h * 64, lane); }
    }
    {
        float m = -INFINITY, l = 0.f; f32x16 o[2] = {};
#pragma unroll 1
        for (int st = 0; st < 4; ++st) {
            const int hp = st >> 1, half = st & 1, h = 2 * hp + wh, j = 4 + 2 * st;
            f32x16 s[4]; float f; u32x4 zv[4];
            { MIX_LANES(); (void)qoff;
              if (half == 0) { m = -INFINITY; l = 0.f; o[0] = (f32x16){}; o[1] = (f32x16){}; }
              MIX_BAR();
              write_v_x(R1, L1, tid);
              load_z4(zv, PROJ + PZ_OFF + (size_t)(12 + h) * MT * 64 + wrow0 * 64, lane);
              load_half(R1, tile_src(j + 3), tid);
              const LAS unsigned char* Kt = L0 + wh * X_KH;
#pragma unroll
              for (int t = 0; t < 4; ++t) s[t] = qk_block(Kt, 32 * t, qf, r32, hi, (f32x16){});
              float mloc = -INFINITY;
#pragma unroll
              for (int t = 0; t < 4; ++t)
#pragma unroll
                  for (int r = 0; r < 16; ++r) mloc = fmaxf(mloc, s[t][r]);
              mloc = fmaxf(mloc, __shfl_xor(mloc, 32));
              const float mn = fmaxf(m, mloc); f = __builtin_amdgcn_exp2f(m - mn);
              float ls = 0.f;
#pragma unroll
              for (int t = 0; t < 4; ++t)
#pragma unroll
                  for (int r = 0; r < 16; ++r) { const float p = __builtin_amdgcn_exp2f(s[t][r] - mn); s[t][r] = p; ls += p; }
              ls += __shfl_xor(ls, 32);
              l = l * f + ls; m = mn; }
            { MIX_LANES();
              MIX_BAR();
              if (st < 3) write_k(R0, L0, false, tid); else write_g(R0, L0, vgb, 0, tid);
              load_q4(qf, PROJ + PMQ_OFF + (size_t)(2 * (st < 3 ? ((st + 1) >> 1) : hp) + wh) * MT * 64 + qoff);
              load_half(R0, tile_src(j + 4), tid);
              if (half == 1) {
                  if (hi == 0) wsf[r32] = f;
                  LDS_WAIT();
#pragma unroll
                  for (int r = 0; r < 16; ++r) { const float fr = wsf[crow(r, hi)]; o[0][r] *= fr; o[1][r] *= fr; }
                  LDS_WAIT();
              }
              const LAS unsigned char* Vt = L1 + wh * X_VH;
#pragma unroll
              for (int t = 0; t < 4; ++t) pv_block(o, s[t], Vt, X_VSTR, 32 * t, lane);
              if (half == 1) attn_out(o, __builtin_amdgcn_rcpf(l), stg, wsf, zv, Y + wrow0 * D_MODEL + 768 + h * 64, lane); }
        }
    }
#pragma unroll 1
    for (int gp = 0; gp < 2; ++gp) {
        const int g = 2 * gp + wh, nks = 2 * rb + 2, j = 12 + 2 * gp;
        f32x16 acc[4] = {}; u32x4 uv[8], zv[8]; bf16x8 af[8];
        { MIX_LANES(); (void)qoff;
          const bf16_t* wrow = WSP + ((size_t)(g * 128 + 32 * rb + r32)) * 128 + 8 * hi;
#pragma unroll
          for (int ks = 0; ks < 8; ++ks) af[ks] = *(const bf16x8*)(wrow + 16 * ks);
          MIX_BAR();
          write_g(R1, L1, vgb, gp, tid);
#pragma unroll
          for (int i = 0; i < 8; ++i) { const size_t row = wrow0 + i * 4 + (lane >> 4); const int ch = lane & 15;
              uv[i] = __builtin_nontemporal_load((const u32x4*)(PROJ + PU_OFF + (size_t)g * MT * 128 + row * 128 + ch * 8));
              zv[i] = __builtin_nontemporal_load((const u32x4*)(PROJ + PZ_OFF + (size_t)(2 * g + (ch >> 3)) * MT * 64 + row * 64 + (ch & 7) * 8)); }
          load_half(R1, tile_src(j + 3), tid);
          const LAS unsigned char* tb = L0 + wh * G_GRP + (8 * hi + ((lane >> 2) & 3)) * 64 + ((lane >> 4) & 1) * 32 + (lane & 3) * 8;
#pragma unroll
          for (int ks = 0; ks < 4; ++ks) if (ks < nks) {
#pragma unroll
              for (int cb = 0; cb < 4; ++cb) {
                  const s16x4 lo = vtr(tb + cb * G_CSTR + ks * 1024), hi4 = vtr(tb + cb * G_CSTR + ks * 1024 + 256);
                  const bf16x8 bfv = {lo[0], lo[1], lo[2], lo[3], hi4[0], hi4[1], hi4[2], hi4[3]};
                  acc[cb] = __builtin_amdgcn_mfma_f32_32x32x16_bf16(af[ks], bfv, acc[cb], 0, 0, 0);
              }
          } }
        { MIX_LANES(); (void)qoff;
          MIX_BAR();
          if (gp == 0) write_g(R0, L0, vgb, 1, tid);
          load_half(R0, tile_src(j + 4), tid);
          const LAS unsigned char* tb = L1 + wh * G_GRP + (8 * hi + ((lane >> 2) & 3)) * 64 + ((lane >> 4) & 1) * 32 + (lane & 3) * 8;
#pragma unroll
          for (int ks = 4; ks < 8; ++ks) if (ks < nks) {
#pragma unroll
              for (int cb = 0; cb < 4; ++cb) {
                  const s16x4 lo = vtr(tb + cb * G_CSTR + (ks - 4) * 1024), hi4 = vtr(tb + cb * G_CSTR + (ks - 4) * 1024 + 256);
                  const bf16x8 bfv = {lo[0], lo[1], lo[2], lo[3], hi4[0], hi4[1], hi4[2], hi4[3]};
                  acc[cb] = __builtin_amdgcn_mfma_f32_32x32x16_bf16(af[ks], bfv, acc[cb], 0, 0, 0);
              }
          }
          LAS bf16_t* st = (LAS bf16_t*)stg;
#pragma unroll
          for (int r = 0; r < 16; ++r) { const int t = crow(r, hi); const float bs = bstab[g * 128 + 32 * rb + t];
#pragma unroll
              for (int cb = 0; cb < 4; ++cb) st[t * 128 + cb * 32 + r32] = (bf16_t)f2bf(acc[cb][r] + bs); }
          LDS_WAIT();
#pragma unroll
          for (int i = 0; i < 8; ++i) { const int row = i * 4 + (lane >> 4), ch = lane & 15;
              const u32x4 sv = *(const LAS u32x4*)(stg + row * 256 + ch * 16);
              *(u32x4*)(Y + (wrow0 + row) * D_MODEL + g * 128 + ch * 8) = mul8x3(sv, uv[i], zv[i]); }
          LDS_WAIT(); }
    }
    { MIX_BAR(); }
#undef MIX_LANES
#undef MIX_BAR
}
}

__global__ void __launch_bounds__(NWAVES * 64, 2) hymba_fwd(Args args) {
    extern __shared__ __attribute__((aligned(16))) unsigned char lds_raw[];
    LAS unsigned char* lds = (LAS unsigned char*)lds_raw;
    volatile LAS unsigned* MISC = (volatile LAS unsigned*)(lds + MISC_OFF);
    const int tid = threadIdx.x, lane = tid & 63, wave = __builtin_amdgcn_readfirstlane(tid >> 6);
    const int G = gridDim.x; const int bx = blockIdx.x; const int vcu = (G % 8 == 0) ? (bx % 8) * (G / 8) + bx / 8 : bx;
    unsigned char* ws = args.ws;
    unsigned* ctl = (unsigned*)(ws + WS_CTL);
    bf16_t* WIN_T = (bf16_t*)(ws + WS_WIN); bf16_t* WOUT_T = (bf16_t*)(ws + WS_WOUT); bf16_t* WSP = (bf16_t*)(ws + WS_WSP); float* SSP = (float*)(ws + WS_SSP);
    bf16_t* XN = (bf16_t*)(ws + WS_XN); bf16_t* PROJ = (bf16_t*)(ws + WS_PROJ); bf16_t* MKV = (bf16_t*)(ws + WS_MKV); bf16_t* Y = (bf16_t*)(ws + WS_Y); bf16_t* O = (bf16_t*)(ws + WS_O);
    for (int u = tid; u < (LDS_BYTES - LDSCTL_OFF) / 4; u += NWAVES * 64) ((LAS unsigned*)(lds + LDSCTL_OFF))[u] = 0u;
    __syncthreads();
    const int NG = (G == 256) ? 2 : 1, Gg = G / NG, grp = bx / Gg, cg = bx - grp * Gg;
    const int vcug = (Gg % 8 == 0) ? (cg % 8) * (Gg / 8) + cg / 8 : cg;
    const int MH = M_TOK / NG, MMH = M_MEM / NG, row_base = grp * MH, pm_base = row_base / 256;
    XcdBarrier barG = xcd_barrier_post(ctl + CW_BAR, MISC + 8, (unsigned)G);
    XcdBarrier barH = barG;
    if (NG == 2) barH = xcd_barrier_post(ctl + CW_BAR + (1 + grp) * XCD_BAR_WORDS, MISC + 10, (unsigned)Gg);
    const int gw = vcu * NWAVES + wave, NGW = G * NWAVES, gwg = vcug * NWAVES + wave, NGWg = Gg * NWAVES;

    {
        rms_rows_to_bf16<4>(args.x, args.g_pre, XN, gw, MH, NGW, lane);
        rms_rows_to_bf16<2>(args.mem, args.g_mem, XN + (size_t)M_TOK * D_MODEL, gw, M_MEM, NGW, lane);
        LAS float* scr = (LAS float*)(lds + wave * 16384);
        constexpr int I_IN = (D_MODEL / 64) * (IN_WIDTH / 32), I_MKV = (D_MODEL / 64) * (MKV_W / 32), I_OUT = (D_MODEL / 64) * (D_MODEL / 32);
        for (int it = NGW - 1 - gw; it < I_IN + I_MKV + I_OUT; it += NGW) {
            int r = it;
            if (r < I_IN) { p0_transpose_item(args.w_in, D_MODEL, IN_WIDTH, WIN_T, 0, scr, r, lane); continue; } r -= I_IN;
            if (r < I_MKV) { p0_transpose_item(args.w_mkv, D_MODEL, MKV_W, WIN_T, IN_WIDTH, scr, r, lane); continue; } r -= I_MKV;
            p0_transpose_item(args.w_out, D_MODEL, D_MODEL, WOUT_T, 0, scr, r, lane);
        }
        for (int e = bx * 512 + tid; e < 4 * 128 * 128; e += G * 512) { const int s = e & 127, t = (e >> 7) & 127; WSP[e] = (bf16_t)f2bf(s <= t ? args.wsp[e] : 0.f); }
        xcd_barrier(barG);
    }
    if (grp == 1) {
        rms_rows_to_bf16<4>(args.x + (size_t)row_base * D_MODEL, args.g_pre, XN + (size_t)row_base * D_MODEL, gwg, MH, NGWg, lane);
        xcd_barrier(barH);
    }
    {
        pg8::Gemm g{XN + (size_t)row_base * D_MODEL, WIN_T, MH, IN_WIDTH + MKV_W, D_MODEL};
        pg8::MergedOrder S; S.S.init(MH, IN_WIDTH, Gg, cg, NG == 2 ? 4 : 8); S.eM = MMH / 256; S.eN = MKV_W / 256; S.ePm0 = (M_TOK + grp * MMH - row_base) / 256;
        EpiProj E{PROJ, MKV, pm_base, S.ePm0, grp * (BATCH / NG)};
        pg8::gemm_phase<EpiProj, pg8::MergedOrder, true, true>(lds, g, S, E);
        xcd_barrier(barH);
    }
    {
        for (int idx = tid; idx < 5 * 192; idx += NWAVES * 64) { const int h = idx / 192, dist = 159 - (idx % 192);
            ((LAS float*)(lds + mix::BIAS_OFF))[idx] = (h < 4 && dist >= 0 && dist < 128) ? args.relb[t5_bucket(dist) * 4 + h] * LOG2E : -INFINITY; }
        if (tid < 4) ((LAS float*)(lds + mix::BIAS_OFF))[5 * 192 + tid] = args.sinks[tid] * LOG2E;
        ((LAS float*)(lds + mix::BSP_OFF))[tid] = args.bsp[tid];
        ((LAS float*)(lds + mix::VGB_OFF))[tid] = args.vg[tid]; ((LAS float*)(lds + mix::VGB_OFF))[512 + tid] = args.vb[tid];
        __syncthreads();
        const int nu = BATCH * (SEQ / CHUNK) / NG;
        for (int u = vcug; u < nu; u += Gg) mix::mix_unit(grp * nu + u, lds, PROJ, MKV, WSP, Y, tid, wave);
        xcd_barrier(barH);
    }
    {
        pg8::Gemm g{Y + (size_t)row_base * D_MODEL, WOUT_T, MH, D_MODEL, D_MODEL};
        pg8::StaticOrder S; S.init(MH, D_MODEL, Gg, cg, NG == 2 ? 4 : 8);
        EpiOut E{O, SSP, pm_base};
        pg8::gemm_phase<EpiOut, pg8::StaticOrder, true, true>(lds, g, S, E);
        xcd_barrier(barH);
    }
    {
        const GAS f32x4* gp = (const GAS f32x4*)args.g_post + lane;
        f32x4 gg[4];
#pragma unroll
        for (int j = 0; j < 4; ++j) gg[j] = gp[64 * j];
        constexpr int NB = 4;
        const int m_end = row_base + MH;
        for (int m0 = row_base + gwg; m0 < m_end; m0 += NB * NGWg) {
            v2u ov[NB][4]; f32x4 xv[NB][4]; float ssp[NB];
#pragma unroll
            for (int i = 0; i < NB; ++i) { const int m = (m0 + i * NGWg < m_end) ? m0 + i * NGWg : m0;
                const GAS v2u* orow = (const GAS v2u*)(O + (size_t)m * D_MODEL) + lane; const GAS f32x4* xr = (const GAS f32x4*)(args.x + (size_t)m * D_MODEL) + lane;
#pragma unroll
                for (int j = 0; j < 4; ++j) { ov[i][j] = __builtin_nontemporal_load(&orow[64 * j]); xv[i][j] = __builtin_nontemporal_load(&xr[64 * j]); }
                ssp[i] = SSP[(size_t)m * 16 + (lane & 15)]; }
#pragma unroll
            for (int i = 0; i < NB; ++i) { const int m = m0 + i * NGWg;
                const float r = rsqrtf(wave_sum(ssp[i]) * 0.25f * (1.f / D_MODEL) + EPS);
                if (m < m_end) {
                    GAS f32x4* outr = (GAS f32x4*)(args.out + (size_t)m * D_MODEL) + lane;
#pragma unroll
                    for (int j = 0; j < 4; ++j) { f32x4 o;
                        o.x = xv[i][j].x + bflo(ov[i][j].x) * r * gg[j].x; o.y = xv[i][j].y + bfhi(ov[i][j].x) * r * gg[j].y; o.z = xv[i][j].z + bflo(ov[i][j].y) * r * gg[j].z; o.w = xv[i][j].w + bfhi(ov[i][j].y) * r * gg[j].w;
                        __builtin_nontemporal_store(o, &outr[64 * j]); }
                }
            }
        }
    }
}

extern "C" void kernel_launch(void* const* d_in, const int* in_sizes, int n_in, void* d_out, int out_size, void* d_ws, size_t ws_size, hipStream_t stream) {
    static int grid = 0;
    if (grid == 0) {
        if (n_in != 14 || in_sizes[0] != M_TOK * D_MODEL || out_size != M_TOK * D_MODEL || ws_size < WS_END) { fprintf(stderr, "kernel_launch: unexpected shapes (n_in %d, ws %zu)\n", n_in, ws_size); grid = -1; return; }
        int dev = 0, cus = 0, per_cu = 0;
        if (hipGetDevice(&dev) != hipSuccess || hipDeviceGetAttribute(&cus, hipDeviceAttributeMultiprocessorCount, dev) != hipSuccess) { grid = -1; return; }
        if (hipFuncSetAttribute((const void*)hymba_fwd, hipFuncAttributeMaxDynamicSharedMemorySize, LDS_BYTES) != hipSuccess) { fprintf(stderr, "kernel_launch: hipFuncSetAttribute failed\n"); grid = -1; return; }
        if (hipOccupancyMaxActiveBlocksPerMultiprocessor(&per_cu, (const void*)hymba_fwd, NWAVES * 64, LDS_BYTES) != hipSuccess || per_cu < 1) { fprintf(stderr, "kernel_launch: occupancy query says %d blocks/CU\n", per_cu); per_cu = 1; }
        (void)hipGetLastError();
        grid = cus;
    }
    if (grid < 0) return;
    (void)hipMemsetAsync((char*)d_ws + WS_CTL, 0, CTL_ZERO_BYTES, stream);
    Args a{};
    a.x = (const float*)d_in[0]; a.mem = (const float*)d_in[1]; a.g_pre = (const float*)d_in[2]; a.g_post = (const float*)d_in[3]; a.g_mem = (const float*)d_in[4];
    a.w_in = (const float*)d_in[5]; a.w_mkv = (const float*)d_in[6]; a.vg = (const float*)d_in[7]; a.vb = (const float*)d_in[8]; a.wsp = (const float*)d_in[9]; a.bsp = (const float*)d_in[10];
    a.sinks = (const float*)d_in[11]; a.relb = (const float*)d_in[12]; a.w_out = (const float*)d_in[13];
    a.out = (float*)d_out; a.ws = (unsigned char*)d_ws;
    hipLaunchKernelGGL(hymba_fwd, dim3(grid), dim3(NWAVES * 64), LDS_BYTES, stream, a);
}
```

```cpp
#include <hip/hip_runtime.h>
#include <cstdio>
#include <cstdint>

namespace pg8 {
#define PG8_LAS __attribute__((address_space(3)))
typedef unsigned short bf16_t;
typedef short bf16x8 __attribute__((ext_vector_type(8)));
typedef float f32x4 __attribute__((ext_vector_type(4)));
typedef unsigned u32x4 __attribute__((ext_vector_type(4)));
constexpr int BM = 256, BK = 64, HALF = 128, HTB = HALF * BK * 2, STAGE_BYTES = 8 * HTB, NXCD = 8, WGM = 8;

__host__ __device__ __forceinline__ int lds_byte(int r, int c) { const int st = (r >> 4) * 2 + (c >> 5), rr = r & 15, cc = c & 31, ob = rr * 64 + cc * 2; return st * 1024 + (ob ^ (((ob >> 9) & 1) << 5)); }
__host__ __device__ __forceinline__ void stage_rc(int b, int& R, int& C) { const int st = b / 1024, sb = b % 1024, swz = sb ^ (((sb >> 9) & 1) << 5); R = (st >> 1) * 16 + swz / 64; C = (st & 1) * 32 + (swz % 64) / 2; }
__host__ __device__ __forceinline__ int perm32(int rho) { const int n = rho >> 4, i = rho & 15; return 8 * (i >> 2) + 4 * n + (i & 3); }

struct Unit { int pm, pn; };
struct Gemm { const bf16_t* A; const bf16_t* Bt; int M, N, K; };

struct StaticOrder {
    int nM, nN, nwg, G, c, wgm;
    __host__ __device__ void init(int M, int N, int G_, int c_, int wgm_ = WGM) { nM = M / BM; nN = N / BM; nwg = nM * nN; G = G_; c = c_; wgm = wgm_; }
    __host__ __device__ void map(int wgid, Unit& u) const {
        { const int q = nwg / NXCD, r = nwg % NXCD, xcd = wgid % NXCD, off = wgid / NXCD; wgid = (xcd < r ? xcd * (q + 1) : r * (q + 1) + (xcd - r) * q) + off; }
        const int nig = wgm * nN, gid = wgid / nig, fm = gid * wgm, gsz = (nM - fm) < wgm ? (nM - fm) : wgm;
        u.pm = fm + ((wgid % nig) % gsz); u.pn = (wgid % nig) / gsz;
    }
    __host__ __device__ bool next(int i, Unit& u) const { const long L = (long)i * G + c; if (L >= nwg) return false; map((int)L, u); return true; }
    __device__ __forceinline__ void a_ready(const Unit&) const {}
    __device__ __forceinline__ void done(const Unit&) const {}
};
struct MergedOrder {
    StaticOrder S; int eM, eN, ePm0;
    __host__ __device__ bool next(int i, Unit& u) const {
        const int G = S.G, c = S.c, nfull = S.nwg / G, rem = S.nwg - nfull * G, nx = eM * eN;
        if (nfull < 1 || rem + 2 * nx > G) {
            if (S.next(i, u)) return true;
            const long L = (long)i * G + c - S.nwg; if (L >= (long)nx) return false;
            u.pm = ePm0 + (int)(L / eN); u.pn = S.nN + (int)(L % eN); return true;
        }
        if (c >= rem && c < rem + nx) {
            if (i < nfull - 1) return S.next(i, u);
            if (i > nfull - 1) return false;
            const int e = c - rem; u.pm = ePm0 + e / eN; u.pn = S.nN + e % eN; return true;
        }
        if (c >= rem + nx && c < rem + 2 * nx) {
            if (i < nfull) return S.next(i, u);
            if (i > nfull) return false;
            S.map((nfull - 1) * G + (c - nx), u); return true;
        }
        return S.next(i, u);
    }
    __device__ __forceinline__ void a_ready(const Unit&) const {}
    __device__ __forceinline__ void done(const Unit&) const {}
};

__device__ __forceinline__ unsigned cvt_pk_bf16(float lo, float hi) { unsigned r; asm volatile("v_cvt_pk_bf16_f32 %0, %1, %2" : "=v"(r) : "v"(lo), "v"(hi)); return r; }

template <class Epi, class Sched, bool ALIGN_EPI = false, bool SP2 = false>
__device__ __forceinline__ void gemm_phase(PG8_LAS unsigned char* lds, const Gemm g, const Sched& S, const Epi& E) {
    const int tid = threadIdx.x, wid = __builtin_amdgcn_readfirstlane(tid >> 6), lane = tid & 63, wr = wid >> 2, wc = wid & 3, fr = lane & 15, fq = lane >> 4;
    const int K = g.K, nt = K / BK;
    unsigned voffA[2], voffB[2];
#pragma unroll
    for (int i = 0; i < 2; ++i) { int R, C; stage_rc(tid * 16 + i * 8192, R, C); const int Rb = Epi::PERM ? ((R & ~31) + perm32(R & 31)) : R;
        voffA[i] = (unsigned)(R * K + C) * 2u; voffB[i] = (unsigned)(Rb * K + C) * 2u; }
    const size_t kstep = (size_t)(BK * 2);
    const size_t hstep = (size_t)HALF * K * 2;
    const size_t tstep = 2 * hstep;
    const unsigned ldsw = (unsigned)wid * 1024u;
    const int aoff = lds_byte(wr * 64 + fr, fq * 8), boff = lds_byte(wc * 32 + fr, fq * 8);
#define PG8_SA(b, h) (((b) * 2 + (h)) * HTB)
#define PG8_SB(b, h) ((4 + (b) * 2 + (h)) * HTB)
#define PG8_STAGE(bufoff, gbase, voff) do { _Pragma("unroll") for (int _i = 0; _i < 2; ++_i) \
        __builtin_amdgcn_global_load_lds((const unsigned*)((const char*)(gbase) + (voff)[_i]), (PG8_LAS unsigned*)(lds + (bufoff) + ldsw + _i * 8192), 16, 0, 0); } while (0)
#define PG8_LDA(dst, b, h) do { _Pragma("unroll") for (int m = 0; m < 4; ++m) _Pragma("unroll") for (int k = 0; k < 2; ++k) dst[m][k] = *(const PG8_LAS bf16x8*)(lds + PG8_SA(b, h) + aoff + m * 2048 + k * 1024); } while (0)
#define PG8_LDB(dst, b, h) do { _Pragma("unroll") for (int n = 0; n < 2; ++n) _Pragma("unroll") for (int k = 0; k < 2; ++k) dst[n][k] = *(const PG8_LAS bf16x8*)(lds + PG8_SB(b, h) + boff + n * 2048 + k * 1024); } while (0)
#define PG8_MMA(ai, bj, At, Bt) do { __builtin_amdgcn_s_setprio(1); _Pragma("unroll") for (int m = 0; m < 4; ++m) _Pragma("unroll") for (int n = 0; n < 2; ++n) _Pragma("unroll") for (int k = 0; k < 2; ++k) \
        acc[ai][bj][m][n] = __builtin_amdgcn_mfma_f32_16x16x32_bf16(Bt[n][k], At[m][k], acc[ai][bj][m][n], 0, 0, 0); __builtin_amdgcn_s_setprio(0); } while (0)
#define PG8_WAIT_V(n) asm volatile("s_waitcnt vmcnt(" #n ")" ::: "memory")
#define PG8_WAIT_L(n) asm volatile("s_waitcnt lgkmcnt(" #n ")" ::: "memory")
#define PG8_BAR __builtin_amdgcn_s_barrier()
#define PG8_SCHED __builtin_amdgcn_sched_barrier(0)
    Unit cur, nxt; int ui = 0;
    if (!S.next(0, cur)) return;
    f32x4 acc[2][2][4][2];
#pragma unroll
    for (int a = 0; a < 2; ++a)
#pragma unroll
        for (int b = 0; b < 2; ++b)
#pragma unroll
            for (int m = 0; m < 4; ++m)
#pragma unroll
                for (int n = 0; n < 2; ++n) acc[a][b][m][n] = (f32x4){0.f, 0.f, 0.f, 0.f};
    bf16x8 At[4][2], B0[2][2], B1[2][2];
    const char* cA = (const char*)g.A + (size_t)cur.pm * tstep; const char* cB = (const char*)g.Bt + (size_t)cur.pn * tstep;
    S.a_ready(cur);
    if constexpr (SP2) {
        PG8_STAGE(PG8_SB(0, 0), cB, voffB); PG8_STAGE(PG8_SB(0, 1), cB + hstep, voffB); PG8_STAGE(PG8_SA(0, 0), cA, voffA); PG8_STAGE(PG8_SA(0, 1), cA + hstep, voffA);
        if (wr == 1) PG8_BAR;
        PG8_WAIT_V(2); PG8_BAR;
        PG8_STAGE(PG8_SB(1, 0), cB + kstep, voffB); PG8_STAGE(PG8_SA(1, 0), cA + kstep, voffA); PG8_STAGE(PG8_SB(1, 1), cB + hstep + kstep, voffB);
        PG8_WAIT_V(6); PG8_BAR;
    } else {
        PG8_STAGE(PG8_SB(0, 0), cB, voffB); PG8_STAGE(PG8_SA(0, 0), cA, voffA); PG8_STAGE(PG8_SB(0, 1), cB + hstep, voffB); PG8_STAGE(PG8_SA(0, 1), cA + hstep, voffA);
        if (wr == 1) PG8_BAR;
        PG8_WAIT_V(4); PG8_BAR;
        PG8_STAGE(PG8_SB(1, 0), cB + kstep, voffB); PG8_STAGE(PG8_SA(1, 0), cA + kstep, voffA); PG8_STAGE(PG8_SB(1, 1), cB + hstep + kstep, voffB);
        PG8_WAIT_V(6); PG8_BAR;
    }
    for (;;) {
        const bool has_next = S.next(ui + 1, nxt);
        const char* nA = has_next ? (const char*)g.A + (size_t)nxt.pm * tstep : cA; const char* nB = has_next ? (const char*)g.Bt + (size_t)nxt.pn * tstep : cB;
        for (int t = 0; t < nt; t += 2) {
            const bool last = (t == nt - 2);
            const char* a1 = cA + (size_t)(t + 1) * kstep;
            const char* a2 = last ? nA : cA + (size_t)(t + 2) * kstep; const char* b2 = last ? nB : cB + (size_t)(t + 2) * kstep;
            const char* a3 = a2 + kstep; const char* b3 = b2 + kstep;
            if (last && has_next) S.a_ready(nxt);
            if constexpr (SP2) {
            PG8_LDB(B0, 0, 0); PG8_LDB(B1, 0, 1); PG8_SCHED; PG8_LDA(At, 0, 0); PG8_STAGE(PG8_SA(1, 1), a1 + hstep, voffA);
            PG8_WAIT_V(8); PG8_WAIT_L(0); PG8_BAR; PG8_MMA(0, 0, At, B0); PG8_MMA(0, 1, At, B1); PG8_BAR; PG8_SCHED;
            PG8_LDA(At, 0, 1); PG8_STAGE(PG8_SB(0, 0), b2, voffB); PG8_STAGE(PG8_SB(0, 1), b2 + hstep, voffB); PG8_STAGE(PG8_SA(0, 0), a2, voffA);
            PG8_WAIT_V(8); PG8_WAIT_L(0); PG8_BAR; PG8_MMA(1, 0, At, B0); PG8_MMA(1, 1, At, B1); PG8_BAR; PG8_SCHED;
            PG8_LDB(B0, 1, 0); PG8_LDB(B1, 1, 1); PG8_SCHED; PG8_LDA(At, 1, 0); PG8_STAGE(PG8_SA(0, 1), a2 + hstep, voffA);
            PG8_WAIT_V(8); PG8_WAIT_L(0); PG8_BAR; PG8_MMA(0, 0, At, B0); PG8_MMA(0, 1, At, B1); PG8_BAR; PG8_SCHED;
            PG8_LDA(At, 1, 1); PG8_STAGE(PG8_SB(1, 0), b3, voffB); PG8_STAGE(PG8_SB(1, 1), b3 + hstep, voffB); PG8_STAGE(PG8_SA(1, 0), a3, voffA);
            PG8_WAIT_V(8); PG8_WAIT_L(0); PG8_BAR; PG8_MMA(1, 0, At, B0); PG8_MMA(1, 1, At, B1); PG8_BAR; PG8_SCHED;
            } else {
            PG8_LDB(B0, 0, 0); PG8_SCHED; PG8_LDA(At, 0, 0); PG8_STAGE(PG8_SA(1, 1), a1 + hstep, voffA);
            PG8_WAIT_L(8); PG8_BAR; PG8_WAIT_L(0); PG8_MMA(0, 0, At, B0); PG8_BAR; PG8_SCHED;
            PG8_LDB(B1, 0, 1); PG8_STAGE(PG8_SB(0, 0), b2, voffB);
            PG8_BAR; PG8_WAIT_L(0); PG8_MMA(0, 1, At, B1); PG8_BAR;
            PG8_LDA(At, 0, 1); PG8_STAGE(PG8_SA(0, 0), a2, voffA);
            PG8_BAR; PG8_WAIT_L(0); PG8_MMA(1, 0, At, B0); PG8_BAR; PG8_SCHED;
            PG8_STAGE(PG8_SB(0, 1), b2 + hstep, voffB);
            PG8_WAIT_V(6); PG8_BAR; PG8_MMA(1, 1, At, B1); PG8_BAR;
            PG8_LDB(B0, 1, 0); PG8_SCHED; PG8_LDA(At, 1, 0); PG8_STAGE(PG8_SA(0, 1), a2 + hstep, voffA);
            PG8_WAIT_L(8); PG8_BAR; PG8_WAIT_L(0); PG8_MMA(0, 0, At, B0); PG8_BAR; PG8_SCHED;
            PG8_LDB(B1, 1, 1); PG8_STAGE(PG8_SB(1, 0), b3, voffB);
            PG8_BAR; PG8_WAIT_L(0); PG8_MMA(0, 1, At, B1); PG8_BAR;
            PG8_LDA(At, 1, 1); PG8_STAGE(PG8_SA(1, 0), a3, voffA);
            PG8_BAR; PG8_WAIT_L(0); PG8_MMA(1, 0, At, B0); PG8_BAR; PG8_SCHED;
            PG8_STAGE(PG8_SB(1, 1), b3 + hstep, voffB);
            PG8_WAIT_V(6); PG8_BAR; PG8_MMA(1, 1, At, B1); PG8_BAR;
            }
        }
        if constexpr (ALIGN_EPI) { if (wr == 0) PG8_BAR; }
        E(acc, cur, wr, wc, fr, fq); S.done(cur);
        if (!has_next) break;
#pragma unroll
        for (int a = 0; a < 2; ++a)
#pragma unroll
            for (int b = 0; b < 2; ++b)
#pragma unroll
                for (int m = 0; m < 4; ++m)
#pragma unroll
                    for (int n = 0; n < 2; ++n) acc[a][b][m][n] = (f32x4){0.f, 0.f, 0.f, 0.f};
        cur = nxt; cA = nA; cB = nB; ++ui;
        if constexpr (ALIGN_EPI) { if (wr == 1) PG8_BAR; }
    }
    PG8_WAIT_V(0);
    if constexpr (!ALIGN_EPI) { if (wr == 0) PG8_BAR; }
    PG8_BAR;
#undef PG8_SA
#undef PG8_SB
#undef PG8_STAGE
#undef PG8_LDA
#undef PG8_LDB
#undef PG8_MMA
#undef PG8_WAIT_V
#undef PG8_WAIT_L
#undef PG8_BAR
#undef PG8_SCHED
}
}

typedef unsigned short bf16_t;
constexpr int D_MODEL = 1024, BATCH = 16, SEQ = 2048, MEM_LEN = 256, HD = 64, CHUNK = 128;
constexpr int M_TOK = BATCH * SEQ, M_MEM = BATCH * MEM_LEN;
constexpr int A_WIDTH = 512, IN_WIDTH = 2816, MKV_W = 512;
constexpr int C_U = 0, C_V = 512, C_SQ = 1024, C_SK = 1280, C_SV = 1408, C_MQ = 1536, C_Z = 1792;
constexpr size_t MT = (size_t)BATCH * SEQ;
constexpr size_t PU_OFF = 0, PV_OFF = PU_OFF + 4 * MT * 128, PQ_OFF = PV_OFF + 4 * MT * 128, PK_OFF = PQ_OFF + 4 * MT * 64, PVV_OFF = PK_OFF + 2 * MT * 64, PMQ_OFF = PVV_OFF + 2 * MT * 64, PZ_OFF = PMQ_OFF + 4 * MT * 64;
static_assert(PZ_OFF + 16 * MT * 64 == MT * 2816, "blocked PROJ layout covers exactly IN_WIDTH columns");
constexpr size_t MV_OFF = (size_t)BATCH * 4 * MEM_LEN * 64;
constexpr float EPS = 1e-6f;
constexpr float LOG2E = 1.4426950408889634f;
constexpr float QSCALE = 0.125f * LOG2E;
constexpr int NWAVES = 8;

constexpr size_t MiB = 1u << 20;
constexpr size_t WS_CTL = 0, CTL_ZERO_BYTES = 64 * 1024;
constexpr size_t WS_WIN = 2 * MiB;
constexpr size_t WS_WOUT = 10 * MiB;
constexpr size_t WS_WSP = 12 * MiB;
constexpr size_t WS_SSP = 13 * MiB;
constexpr size_t WS_XN = 16 * MiB;
constexpr size_t WS_PROJ = 96 * MiB;
constexpr size_t WS_MKV = 272 * MiB;
constexpr size_t WS_Y = 280 * MiB;
constexpr size_t WS_O = 344 * MiB;
constexpr size_t WS_END = 408 * MiB;
constexpr int CW_BAR = 1024;

constexpr int RING_BYTES = 131072, LDSCTL_OFF = 138240, MISC_OFF = LDSCTL_OFF + 320, LDS_BYTES = 147456;

#define GAS __attribute__((address_space(1)))
#define LAS __attribute__((address_space(3)))
typedef unsigned v4u __attribute__((ext_vector_type(4)));
typedef unsigned v2u __attribute__((ext_vector_type(2)));
typedef float f32x4 __attribute__((ext_vector_type(4)));
#define LDS_WAIT() asm volatile("s_waitcnt lgkmcnt(0)" ::: "memory")
#define VM_WAIT() asm volatile("s_waitcnt vmcnt(0)" ::: "memory")
__device__ __forceinline__ float bf2f(bf16_t v) { return __builtin_bit_cast(float, (unsigned)v << 16); }
__device__ __forceinline__ unsigned f2bf(float f) { unsigned u = __builtin_bit_cast(unsigned, f); return (u + 0x7fffu + ((u >> 16) & 1u)) >> 16; }
__device__ __forceinline__ unsigned pk2(float lo, float hi) { return f2bf(lo) | (f2bf(hi) << 16); }
__device__ __forceinline__ float bflo(unsigned w) { return __builtin_bit_cast(float, w << 16); }
__device__ __forceinline__ float bfhi(unsigned w) { return __builtin_bit_cast(float, w & 0xffff0000u); }
__device__ __forceinline__ float fast_sigmoid_mul(float x, float t) { return x * __builtin_amdgcn_rcpf(1.f + __builtin_amdgcn_exp2f(-t * LOG2E)); }
__device__ __forceinline__ float gelu_tanh(float x) { return fast_sigmoid_mul(x, 1.5957691216057308f * (x + 0.044715f * x * x * x)); }
__device__ __forceinline__ float silu(float x) { return fast_sigmoid_mul(x, x); }
typedef float f32x2 __attribute__((ext_vector_type(2)));
__device__ __forceinline__ f32x2 sigmoid_mul_pk(f32x2 x, f32x2 tneg) {
    f32x2 e; e.x = __builtin_amdgcn_exp2f(tneg.x); e.y = __builtin_amdgcn_exp2f(tneg.y);
    const f32x2 d = e + 1.0f; f32x2 r; r.x = __builtin_amdgcn_rcpf(d.x); r.y = __builtin_amdgcn_rcpf(d.y);
    return x * r;
}
__device__ __forceinline__ f32x2 gelu_tanh_pk(f32x2 x) { const f32x2 x2 = x * x; const f32x2 q = x2 * (-0.044715f * 1.5957691216057308f * LOG2E) + (-1.5957691216057308f * LOG2E); return sigmoid_mul_pk(x, x * q); }
__device__ __forceinline__ f32x2 silu_pk(f32x2 x) { return sigmoid_mul_pk(x, x * (-LOG2E)); }
__device__ __forceinline__ float wave_sum(float v) {
#pragma unroll
    for (int o = 1; o < 64; o <<= 1) v += __shfl_xor(v, o);
    return v;
}

#define XB_TMO      128
#define XB_XCNT(j)  (256  + 64 * (j))
#define XB_XSUB(j)  (1280 + 64 * (j))
#define XB_XGEN(j)  (2304 + 64 * (j))
#define XB_TOP      3328
#define XB_TOPGEN   3392
#define XCD_BAR_WORDS 3456
#define XB_SPIN_CAP (1u << 18)
__device__ __forceinline__ unsigned xb_ld(unsigned* p)              { return __hip_atomic_load(p, __ATOMIC_RELAXED, __HIP_MEMORY_SCOPE_AGENT); }
__device__ __forceinline__ unsigned xb_add(unsigned* p, unsigned v) { return __hip_atomic_fetch_add(p, v, __ATOMIC_RELAXED, __HIP_MEMORY_SCOPE_AGENT); }
__device__ __forceinline__ unsigned xb_xcc_id() { return (unsigned)__builtin_amdgcn_s_getreg((3 << 11) | 20) & 0xFu; }
#define XB_SPIN(cond, bar) do { unsigned _sp = 0; while (cond) { __builtin_amdgcn_s_sleep(1); \
    if ((++_sp & 255u) == 0u) { if (xb_ld(&(bar)[XB_TMO])) break; if (_sp > XB_SPIN_CAP) { atomicAdd(&(bar)[XB_TMO], 1u); break; } } } } while (0)
struct XcdBarrier { unsigned* bar; unsigned x; volatile LAS unsigned* st; unsigned n; };
__device__ __forceinline__ XcdBarrier xcd_barrier_post(unsigned* bar, volatile LAS unsigned* st, unsigned n) {
    XcdBarrier b; b.bar = bar; b.x = xb_xcc_id(); b.st = st; b.n = n;
    if (threadIdx.x == 0) (void)xb_add(&bar[XB_XCNT(b.x)], 1u);
    return b;
}
__device__ __forceinline__ void xcd_barrier_complete(unsigned* bar, unsigned x, unsigned G, unsigned& nloc, unsigned& nx) {
    unsigned sum, cnt, mine, sp = 0u;
    for (;;) {
        sum = 0u; cnt = 0u; mine = 0u;
#pragma unroll
        for (unsigned j = 0; j < 16; ++j) { const unsigned c = xb_ld(&bar[XB_XCNT(j)]); sum += c; cnt += (c > 0u) ? 1u : 0u; mine = (j == x) ? c : mine; }
        if (sum == G) break;
        __builtin_amdgcn_s_sleep(1);
        if ((++sp & 255u) == 0u) { if (xb_ld(&bar[XB_TMO])) break; if (sp > XB_SPIN_CAP) { atomicAdd(&bar[XB_TMO], 1u); break; } }
    }
    nloc = mine > 0u ? mine : 1u; nx = cnt > 0u ? cnt : 1u;
}
__device__ __forceinline__ void xcd_barrier(const XcdBarrier& b) {
    asm volatile("s_waitcnt vmcnt(0)" ::: "memory");
    __syncthreads();
    if (threadIdx.x == 0) {
        unsigned* bar = b.bar;
        __builtin_amdgcn_s_waitcnt(0);
        unsigned nloc = b.st[0], nx = b.st[1];
        if (nloc == 0u) { xcd_barrier_complete(bar, b.x, b.n, nloc, nx); b.st[0] = nloc; b.st[1] = nx; }
        const unsigned old = xb_add(&bar[XB_XSUB(b.x)], 1u);
        const unsigned gen = old / nloc;
        if (old + 1u == (gen + 1u) * nloc) {
            __builtin_amdgcn_fence(__ATOMIC_RELEASE, "agent");
            asm volatile("s_waitcnt vmcnt(0)" ::: "memory");
            const unsigned og = xb_add(&bar[XB_TOP], 1u);
            const unsigned tg = og / nx;
            if (og + 1u == (tg + 1u) * nx) xb_add(&bar[XB_TOPGEN], 1u);
            else XB_SPIN(xb_ld(&bar[XB_TOPGEN]) == tg, bar);
            __builtin_amdgcn_fence(__ATOMIC_ACQUIRE, "agent");
            xb_add(&bar[XB_XGEN(b.x)], 1u);
            asm volatile("s_waitcnt vmcnt(0)" ::: "memory");
        } else {
            XB_SPIN(xb_ld(&bar[XB_XGEN(b.x)]) == gen, bar);
            __builtin_amdgcn_fence(__ATOMIC_ACQUIRE, "agent");
            asm volatile("s_waitcnt vmcnt(0)" ::: "memory");
        }
    }
    __syncthreads();
}

struct Args {
    const float *x, *mem, *g_pre, *g_post, *g_mem, *w_in, *w_mkv, *vg, *vb, *wsp, *bsp, *sinks, *relb, *w_out;
    float* out; unsigned char* ws;
};

__device__ __forceinline__ void p0_transpose_item(const float* W, int K, int N, bf16_t* WT, int row_off, LAS float* scr, int item, int lane) {
    const int nblk = N / 32, kb = item / nblk, nb = item % nblk, k0 = 64 * kb, n0 = 32 * nb;
    float wv[32];
#pragma unroll
    for (int i = 0; i < 32; ++i) wv[i] = W[(size_t)(k0 + 2 * i + (lane >> 5)) * N + n0 + (lane & 31)];
#pragma unroll
    for (int i = 0; i < 32; ++i) scr[(2 * i + (lane >> 5)) * 33 + (lane & 31)] = wv[i];
    LDS_WAIT(); asm volatile("" ::: "memory");
    const int c = lane & 7;
#pragma unroll
    for (int j = 0; j < 4; ++j) { const int n = (lane >> 3) + 8 * j; const LAS float* s = scr + (8 * c) * 33 + n;
        v4u o; o.x = pk2(s[0 * 33], s[1 * 33]); o.y = pk2(s[2 * 33], s[3 * 33]); o.z = pk2(s[4 * 33], s[5 * 33]); o.w = pk2(s[6 * 33], s[7 * 33]);
        *(GAS v4u*)(WT + (size_t)(row_off + n0 + n) * K + k0 + 8 * c) = o; }
    LDS_WAIT(); asm volatile("" ::: "memory");
}
template <int NB> __device__ __forceinline__ void rms_rows_to_bf16(const float* src, const float* g, bf16_t* dst, int m0, int m1, int step, int lane) {
    if (m0 >= m1) return;
    const int mlast = m0 + ((m1 - 1 - m0) / step) * step;
    const GAS f32x4* gr = (const GAS f32x4*)g + lane;
    f32x4 gg[4];
#pragma unroll
    for (int j = 0; j < 4; ++j) gg[j] = gr[64 * j];
    f32x4 v[NB][4], nx[NB][4];
#pragma unroll
    for (int i = 0; i < NB; ++i) { const int mr = m0 + i * step < mlast ? m0 + i * step : mlast; const GAS f32x4* xr = (const GAS f32x4*)(src + (size_t)mr * D_MODEL) + lane;
#pragma unroll
        for (int j = 0; j < 4; ++j) v[i][j] = __builtin_nontemporal_load(&xr[64 * j]); }
    for (int m = m0; m < m1; m += NB * step) {
#pragma unroll
        for (int i = 0; i < NB; ++i) { const int mn = m + (NB + i) * step, mr = mn < mlast ? mn : mlast; const GAS f32x4* xr = (const GAS f32x4*)(src + (size_t)mr * D_MODEL) + lane;
#pragma unroll
            for (int j = 0; j < 4; ++j) nx[i][j] = __builtin_nontemporal_load(&xr[64 * j]); }
#pragma unroll
        for (int i = 0; i < NB; ++i) {
            const int mi = m + i * step;
            float s = 0.f;
#pragma unroll
            for (int j = 0; j < 4; ++j) s += (v[i][j].x * v[i][j].x + v[i][j].y * v[i][j].y) + (v[i][j].z * v[i][j].z + v[i][j].w * v[i][j].w);
            const float r = rsqrtf(wave_sum(s) * (1.f / D_MODEL) + EPS);
            if (mi < m1) {
                GAS v2u* o8 = (GAS v2u*)(dst + (size_t)mi * D_MODEL) + lane;
#pragma unroll
                for (int j = 0; j < 4; ++j) { v2u w; w.x = pk2(v[i][j].x * r * gg[j].x, v[i][j].y * r * gg[j].y); w.y = pk2(v[i][j].z * r * gg[j].z, v[i][j].w * r * gg[j].w); o8[64 * j] = w; }
            }
        }
#pragma unroll
        for (int i = 0; i < NB; ++i)
#pragma unroll
            for (int j = 0; j < 4; ++j) v[i][j] = nx[i][j];
    }
}

struct EpiProj {
    static constexpr bool PERM = true;
    bf16_t* PROJ; bf16_t* MKV; int pm_base, mem_pm0, mem_b0;
    template <int ACT> __device__ __forceinline__ void tile(const pg8::f32x4 (&acc)[2][2][4][2], bf16_t* b0, bf16_t* b1, int pitch) const {
#pragma unroll
        for (int ai = 0; ai < 2; ++ai)
#pragma unroll
            for (int m = 0; m < 4; ++m) { const size_t ro = (size_t)(ai * 128 + m * 16) * pitch;
#pragma unroll
                for (int bj = 0; bj < 2; ++bj) { f32x2 p[4];
#pragma unroll
                    for (int e = 0; e < 2; ++e) { p[e] = (f32x2){acc[ai][bj][m][0][2 * e], acc[ai][bj][m][0][2 * e + 1]}; p[2 + e] = (f32x2){acc[ai][bj][m][1][2 * e], acc[ai][bj][m][1][2 * e + 1]}; }
#pragma unroll
                    for (int e = 0; e < 4; ++e) { if (ACT == 1) p[e] = gelu_tanh_pk(p[e]); else if (ACT == 2) p[e] = p[e] * QSCALE; else if (ACT == 3) p[e] = silu_pk(p[e]); }
                    pg8::u32x4 w; w.x = pg8::cvt_pk_bf16(p[0].x, p[0].y); w.y = pg8::cvt_pk_bf16(p[1].x, p[1].y); w.z = pg8::cvt_pk_bf16(p[2].x, p[2].y); w.w = pg8::cvt_pk_bf16(p[3].x, p[3].y);
                    *(pg8::u32x4*)((bj ? b1 : b0) + ro) = w; } }
    }
    __device__ __forceinline__ void operator()(const pg8::f32x4 (&acc)[2][2][4][2], const pg8::Unit& u, int wr, int wc, int fr, int fq) const {
        const int c128 = wc * 32 + 8 * fq, c64 = (wc & 1) * 32 + 8 * fq, k64 = wc >> 1;
        if (u.pn < 11) {
            const size_t row = (size_t)(pm_base + u.pm) * 256 + wr * 64 + fr;
            if (u.pn < 4) {
                bf16_t* base = PROJ + (u.pn < 2 ? PU_OFF : PV_OFF) + (size_t)(2 * (u.pn & 1)) * MT * 128 + row * 128 + c128;
                tile<1>(acc, base, base + MT * 128, 128);
            } else if (u.pn == 4 || u.pn == 6) {
                bf16_t* base = PROJ + (u.pn == 4 ? PQ_OFF : PMQ_OFF) + (size_t)k64 * MT * 64 + row * 64 + c64;
                tile<2>(acc, base, base + 2 * MT * 64, 64);
            } else if (u.pn == 5) {
                bf16_t* base = PROJ + PK_OFF + (size_t)k64 * MT * 64 + row * 64 + c64;
                tile<0>(acc, base, base + (PVV_OFF - PK_OFF), 64);
            } else {
                bf16_t* base = PROJ + PZ_OFF + (size_t)(4 * (u.pn - 7) + k64) * MT * 64 + row * 64 + c64;
                tile<3>(acc, base, base + 2 * MT * 64, 64);
            }
        } else {
            const int b = mem_b0 + (u.pm - mem_pm0); const size_t key = (size_t)wr * 64 + fr;
            bf16_t* base = MKV + (u.pn - 11) * MV_OFF + ((size_t)(b * 4 + k64) * MEM_LEN + key) * 64 + c64;
            tile<0>(acc, base, base + (size_t)2 * MEM_LEN * 64, 64);
        }
    }
};
struct EpiOut {
    static constexpr bool PERM = true;
    bf16_t* O; float* SSP; int pm_base;
    __device__ __forceinline__ void operator()(const pg8::f32x4 (&acc)[2][2][4][2], const pg8::Unit& u, int wr, int wc, int fr, int fq) const {
        const int row0 = (pm_base + u.pm) * 256 + wr * 64 + fr, col0 = u.pn * 256 + wc * 32 + 8 * fq;
#pragma unroll
        for (int ai = 0; ai < 2; ++ai)
#pragma unroll
            for (int m = 0; m < 4; ++m) { const int row = row0 + ai * 128 + m * 16; bf16_t* rowp = O + (size_t)row * D_MODEL + col0; float ss = 0.f;
#pragma unroll
                for (int bj = 0; bj < 2; ++bj) { const pg8::f32x4 v0 = acc[ai][bj][m][0], v1 = acc[ai][bj][m][1];
                    ss += (v0[0] * v0[0] + v0[1] * v0[1]) + (v0[2] * v0[2] + v0[3] * v0[3]) + (v1[0] * v1[0] + v1[1] * v1[1]) + (v1[2] * v1[2] + v1[3] * v1[3]);
                    pg8::u32x4 w; w.x = pg8::cvt_pk_bf16(v0[0], v0[1]); w.y = pg8::cvt_pk_bf16(v0[2], v0[3]); w.z = pg8::cvt_pk_bf16(v1[0], v1[1]); w.w = pg8::cvt_pk_bf16(v1[2], v1[3]);
                    *(pg8::u32x4*)(rowp + bj * 128) = w; }
                ss += __shfl_xor(ss, 16); ss += __shfl_xor(ss, 32);
                if (fq == 0) SSP[(size_t)row * 16 + u.pn * 4 + wc] = ss; }
    }
};

__device__ __forceinline__ int t5_bucket(int n) {
    if (n < 16) return n;
    int l = 16 + (int)(__logf((float)n * (1.f / 16.f)) * (16.f / 2.0794415416798357f));
    return l < 31 ? l : 31;
}

namespace mix {
typedef short bf16x8 __attribute__((ext_vector_type(8)));
typedef short s16x4 __attribute__((ext_vector_type(4)));
typedef float f32x16 __attribute__((ext_vector_type(16)));
typedef unsigned u32x4 __attribute__((ext_vector_type(4))); typedef unsigned u32x2 __attribute__((ext_vector_type(2)));
typedef float f32x2_t __attribute__((ext_vector_type(2))); typedef __bf16 bf16x2_t __attribute__((ext_vector_type(2)));
constexpr int L1_OFF = 33280, STG_OFF = 66560, STG_WAVE = 8192, BIAS_OFF = 132096  , WSF_OFF = 136192, BSP_OFF = 138752  , VGB_OFF = 140800  ;
constexpr int SWA_VSTR = 256 * 64 + 64;
constexpr int X_KH = 16384, X_VH = 16512, X_VSTR = 128 * 64 + 64;
constexpr int G_GRP = 16640, G_CSTR = 64 * 64 + 64;

__device__ __forceinline__ int crow(int r, int hi) { return (r & 3) + 8 * (r >> 2) + 4 * hi; }
__device__ __forceinline__ s16x4 vtr(const LAS unsigned char* p) { return __builtin_bit_cast(s16x4, __builtin_amdgcn_ds_read_tr16_b64_v4i16((LAS s16x4*)p)); }
__device__ __forceinline__ unsigned cvtpk(float lo, float hi) { f32x2_t v = {lo, hi}; bf16x2_t b = __builtin_convertvector(v, bf16x2_t); return __builtin_bit_cast(unsigned, b); }
__device__ __forceinline__ u32x4 mul8(u32x4 a, u32x4 b) { u32x4 r;
#pragma unroll
    for (int e = 0; e < 4; ++e) r[e] = cvtpk(bflo(a[e]) * bflo(b[e]), bfhi(a[e]) * bfhi(b[e]));
    return r; }
__device__ __forceinline__ u32x4 mul8x3(u32x4 a, u32x4 b, u32x4 c) { u32x4 r;
#pragma unroll
    for (int e = 0; e < 4; ++e) r[e] = cvtpk(bflo(a[e]) * bflo(b[e]) * bflo(c[e]), bfhi(a[e]) * bfhi(b[e]) * bfhi(c[e]));
    return r; }

__device__ __forceinline__ f32x16 qk_block(const LAS unsigned char* Kt, int key0, const bf16x8 (&qf)[4], int r32, int hi, f32x16 s) {
    const int key = key0 + r32, sw = (key >> 1) & 7; const LAS unsigned char* kr = Kt + key * 128;
#pragma unroll
    for (int d0 = 0; d0 < 4; ++d0) { const bf16x8 kf = *(const LAS bf16x8*)(kr + (((2 * d0 + hi) ^ sw) << 4)); s = __builtin_amdgcn_mfma_f32_32x32x16_bf16(kf, qf[d0], s, 0, 0, 0); }
    return s;
}
__device__ __forceinline__ void pv_block(f32x16 (&o)[2], const f32x16& p, const LAS unsigned char* Vt, int vstr, int key0, int lane) {
    const LAS unsigned char* vb = Vt + (key0 + 4 * (lane >> 5) + ((lane >> 2) & 3)) * 64 + ((lane >> 4) & 1) * 32 + (lane & 3) * 8;
#pragma unroll
    for (int s = 0; s < 2; ++s) {
        u32x4 pw; pw[0] = cvtpk(p[8 * s + 0], p[8 * s + 1]); pw[1] = cvtpk(p[8 * s + 2], p[8 * s + 3]); pw[2] = cvtpk(p[8 * s + 4], p[8 * s + 5]); pw[3] = cvtpk(p[8 * s + 6], p[8 * s + 7]);
        const bf16x8 pa = __builtin_bit_cast(bf16x8, pw);
#pragma unroll
        for (int dblk = 0; dblk < 2; ++dblk) {
            const s16x4 lo = vtr(vb + dblk * vstr + s * 1024), hi4 = vtr(vb + dblk * vstr + s * 1024 + 512);
            const bf16x8 vf = {lo[0], lo[1], lo[2], lo[3], hi4[0], hi4[1], hi4[2], hi4[3]};
            o[dblk] = __builtin_amdgcn_mfma_f32_32x32x16_bf16(vf, pa, o[dblk], 0, 0, 0);
        }
    }
}
struct TileSrc { const bf16_t* p; long s_hi; };
__device__ __forceinline__ void load_half(u32x4 (&r)[4], const TileSrc t, int tid) {
    const bf16_t* p = t.p + (long)tid * 8;
#pragma unroll
    for (int it = 0; it < 4; ++it) r[it] = *(const u32x4*)(p + (it >> 1) * t.s_hi + (it & 1) * 4096);
}
__device__ __forceinline__ void write_k(const u32x4 (&r)[4], LAS unsigned char* L, bool zero_lo, int tid) {
    const int ch = tid & 7, kl = tid >> 3; LAS unsigned char* d = L + kl * 128 + ((ch ^ ((kl >> 1) & 7)) << 4);
    const unsigned keep = zero_lo ? 0u : 0xffffffffu;
#pragma unroll
    for (int it = 0; it < 4; ++it) { u32x4 v = r[it]; if (it < 2) { v[0] &= keep; v[1] &= keep; v[2] &= keep; v[3] &= keep; } *(LAS u32x4*)(d + it * 8192) = v; }
}
__device__ __forceinline__ void write_v_swa(const u32x4 (&r)[4], LAS unsigned char* L, bool zero_lo, int tid) {
    const int ch = tid & 7, kl = tid >> 3; LAS unsigned char* d = L + (ch >> 2) * SWA_VSTR + kl * 64 + (ch & 3) * 16;
    const unsigned keep = zero_lo ? 0u : 0xffffffffu;
#pragma unroll
    for (int it = 0; it < 4; ++it) { u32x4 v = r[it]; if (it < 2) { v[0] &= keep; v[1] &= keep; v[2] &= keep; v[3] &= keep; } *(LAS u32x4*)(d + it * 4096) = v; }
}
__device__ __forceinline__ void write_v_x(const u32x4 (&r)[4], LAS unsigned char* L, int tid) {
    const int ch = tid & 7, kl = tid >> 3; LAS unsigned char* d = L + (ch >> 2) * X_VSTR + kl * 64 + (ch & 3) * 16;
#pragma unroll
    for (int it = 0; it < 4; ++it) *(LAS u32x4*)(d + (it >> 1) * X_VH + (it & 1) * 4096) = r[it];
}
__device__ __forceinline__ float row16_sum(float v) {
    v += __shfl_xor(v, 1); v += __shfl_xor(v, 2); v += __shfl_xor(v, 4); v += __shfl_xor(v, 8);
    return v;
}
__device__ __forceinline__ void write_g(const u32x4 (&r)[4], LAS unsigned char* L, const LAS float* vgb, int gp, int tid) {
    const int ch = tid & 15;
#pragma unroll
    for (int it = 0; it < 4; ++it) { const int gl = it >> 1, srow = (it & 1) * 32 + (tid >> 4), g = 2 * gp + gl;
        float v[8];
#pragma unroll
        for (int e = 0; e < 4; ++e) { v[2 * e] = bflo(r[it][e]); v[2 * e + 1] = bfhi(r[it][e]); }
        const float mu = row16_sum(((v[0] + v[1]) + (v[2] + v[3])) + ((v[4] + v[5]) + (v[6] + v[7]))) * (1.f / 128.f); float sq = 0.f;
#pragma unroll
        for (int e = 0; e < 8; ++e) { v[e] -= mu; sq += v[e] * v[e]; }
        const float rs = rsqrtf(row16_sum(sq) * (1.f / 128.f) + EPS);
        const LAS f32x4* gq = (const LAS f32x4*)(vgb + g * 128 + ch * 8); const LAS f32x4* bq = (const LAS f32x4*)(vgb + 512 + g * 128 + ch * 8);
        const f32x4 g0 = gq[0], g1 = gq[1], b0 = bq[0], b1 = bq[1];
        u32x4 w;
        w[0] = cvtpk(v[0] * rs * g0[0] + b0[0], v[1] * rs * g0[1] + b0[1]); w[1] = cvtpk(v[2] * rs * g0[2] + b0[2], v[3] * rs * g0[3] + b0[3]);
        w[2] = cvtpk(v[4] * rs * g1[0] + b1[0], v[5] * rs * g1[1] + b1[1]); w[3] = cvtpk(v[6] * rs * g1[2] + b1[2], v[7] * rs * g1[3] + b1[3]);
        *(LAS u32x4*)(L + gl * G_GRP + (ch >> 2) * G_CSTR + srow * 64 + (ch & 3) * 16) = w; }
}
__device__ __forceinline__ void attn_out(const f32x16 (&o)[2], float rinv, LAS unsigned char* stg, const u32x4 (&zv)[4], bf16_t* yrow0, int lane) {
    const int r32 = lane & 31, hi = lane >> 5;
    LAS unsigned char* wr = stg + r32 * 128 + hi * 8; const int sw = (r32 >> 1) & 7;
#pragma unroll
    for (int dblk = 0; dblk < 2; ++dblk)
#pragma unroll
        for (int rq = 0; rq < 4; ++rq) { u32x2 w; w[0] = cvtpk(o[dblk][4 * rq] * rinv, o[dblk][4 * rq + 1] * rinv); w[1] = cvtpk(o[dblk][4 * rq + 2] * rinv, o[dblk][4 * rq + 3] * rinv);
            *(LAS u32x2*)(wr + (((dblk * 4 + rq) ^ sw) << 4)) = w; }
    LDS_WAIT();
#pragma unroll
    for (int i = 0; i < 4; ++i) { const int row = i * 8 + (lane >> 3), ch = lane & 7;
        const u32x4 v = *(const LAS u32x4*)(stg + row * 128 + ((ch ^ ((row >> 1) & 7)) << 4));
        *(u32x4*)(yrow0 + (size_t)row * D_MODEL + ch * 8) = mul8(v, zv[i]); }
    LDS_WAIT();
}
__device__ __forceinline__ void load_z4(u32x4 (&zv)[4], const bf16_t* zrow0, int lane) {
#pragma unroll
    for (int i = 0; i < 4; ++i) zv[i] = __builtin_nontemporal_load((const u32x4*)(zrow0 + (size_t)(i * 8 + (lane >> 3)) * 64 + (lane & 7) * 8));
}
__device__ __forceinline__ void load_q4(bf16x8 (&q)[4], const bf16_t* qp) {
#pragma unroll
    for (int d0 = 0; d0 < 4; ++d0) q[d0] = *(const bf16x8*)(qp + 16 * d0);
}

__device__ __forceinline__ void mix_unit(int unit, LAS unsigned char* lds, const bf16_t* __restrict__ PROJ, const bf16_t* __restrict__ MKV, const bf16_t* __restrict__ WSP, bf16_t* __restrict__ Y, int tid, int wave) {
    const int b = unit >> 4, n = unit & 15, rb = wave & 3, wh = wave >> 2;
    const size_t row0 = (size_t)b * SEQ + (size_t)n * CHUNK;
    const size_t wrow0 = row0 + 32 * rb;
    LAS unsigned char* const L0 = lds; LAS unsigned char* const L1 = lds + L1_OFF;
    LAS unsigned char* stg = lds + STG_OFF + wave * STG_WAVE;
    const LAS float* btab = (const LAS float*)(lds + BIAS_OFF);
    const LAS float* bstab = (const LAS float*)(lds + BSP_OFF);
    const LAS float* vgb = (const LAS float*)(lds + VGB_OFF);
    const int tid_in = tid;
    const bool first = (n == 0);
#define MIX_BAR() asm volatile("s_waitcnt lgkmcnt(0)\n\ts_barrier" ::: "memory")
#define MIX_LANES() int tid = tid_in; asm volatile("" : "+v"(tid)); const int lane = tid & 63, r32 = lane & 31, hi = lane >> 5; const size_t qoff = (wrow0 + r32) * 64 + 8 * hi;
    auto tile_src = [&](int j) -> TileSrc {
        TileSrc t; j = j > 15 ? 15 : j;
        if (j < 4) { t.p = PROJ + ((j & 1) ? PVV_OFF : PK_OFF) + (size_t)(j >> 1) * MT * 64 + ((long)row0 - 128) * 64; t.s_hi = 8192; }
        else if (j < 12) { const int x = j - 4, st = x >> 1; t.p = MKV + ((x & 1) ? MV_OFF : 0) + ((size_t)(b * 4 + 2 * (st >> 1)) * MEM_LEN + (st & 1) * 128) * 64; t.s_hi = (long)MEM_LEN * 64; }
        else { const int y = j - 12; t.p = PROJ + PV_OFF + (size_t)(2 * (y >> 1)) * MT * 128 + (row0 + (y & 1) * 64) * 128; t.s_hi = (long)MT * 128; }
        return t; };
    u32x4 R0[4], R1[4]; bf16x8 qf[4];
    { MIX_LANES();
      load_half(R0, tile_src(0), tid); load_q4(qf, PROJ + PQ_OFF + (size_t)wh * MT * 64 + qoff);
      MIX_BAR();
      write_k(R0, L0, first, tid);
      load_half(R1, tile_src(1), tid); load_half(R0, tile_src(2), tid); }

#pragma unroll 1
    for (int kvh = 0; kvh < 2; ++kvh) {
        const int h = 2 * kvh + wh, j = 2 * kvh;
        f32x16 s[5]; float rinv; u32x4 zv[4];
        { MIX_LANES(); (void)qoff;
          MIX_BAR();
          write_v_swa(R1, L1, first, tid);
          load_z4(zv, PROJ + PZ_OFF + (size_t)(8 + h) * MT * 64 + wrow0 * 64, lane);
          load_half(R1, tile_src(j + 3), tid);
#pragma unroll
          for (int t = 0; t < 5; ++t) {
              const LAS float* tb = btab + ((first && rb + t < 4) ? 4 : h) * 192 + (31 - r32 + 4 * hi);
#pragma unroll
              for (int r = 0; r < 16; ++r) s[t][r] = tb[32 * t + (r & 3) + 8 * (r >> 2)];
          }
#pragma unroll
          for (int t = 0; t < 5; ++t) s[t] = qk_block(L0, 32 * (rb + t), qf, r32, hi, s[t]);
          const float sink2 = btab[5 * 192 + h]; float m = sink2;
#pragma unroll
          for (int t = 0; t < 5; ++t)
#pragma unroll
              for (int r = 0; r < 16; ++r) m = fmaxf(m, s[t][r]);
          m = fmaxf(m, __shfl_xor(m, 32));
          float l = 0.f;
#pragma unroll
          for (int t = 0; t < 5; ++t)
#pragma unroll
              for (int r = 0; r < 16; ++r) { const float p = __builtin_amdgcn_exp2f(s[t][r] - m); s[t][r] = p; l += p; }
          l += __shfl_xor(l, 32);
          rinv = __builtin_amdgcn_rcpf(l + __builtin_amdgcn_exp2f(sink2 - m)); }
        { MIX_LANES();
          MIX_BAR();
          write_k(R0, L0, kvh == 0 && first, tid);
          load_q4(qf, PROJ + (kvh == 0 ? PQ_OFF + (size_t)(2 + wh) * MT * 64 : PMQ_OFF + (size_t)wh * MT * 64) + qoff);
          load_half(R0, tile_src(j + 4), tid);
          f32x16 o[2] = {};
#pragma unroll
          for (int t = 0; t < 5; ++t) pv_block(o, s[t], L1, SWA_VSTR, 32 * (rb + t), lane);
          attn_out(o, rinv, stg, zv, Y + wrow0 * D_MODEL + 512 + h * 64, lane); }
    }
    {
        float m = -INFINITY, l = 0.f; f32x16 o[2] = {};
#pragma unroll 1
        for (int st = 0; st < 4; ++st) {
            const int hp = st >> 1, half = st & 1, h = 2 * hp + wh, j = 4 + 2 * st;
            f32x16 s[4]; float f; u32x4 zv[4];
            { MIX_LANES(); (void)qoff;
              if (half == 0) { m = -INFINITY; l = 0.f; o[0] = (f32x16){}; o[1] = (f32x16){}; }
              MIX_BAR();
              write_v_x(R1, L1, tid);
              load_z4(zv, PROJ + PZ_OFF + (size_t)(12 + h) * MT * 64 + wrow0 * 64, lane);
              load_half(R1, tile_src(j + 3), tid);
              const LAS unsigned char* Kt = L0 + wh * X_KH;
#pragma unroll
              for (int t = 0; t < 4; ++t) s[t] = qk_block(Kt, 32 * t, qf, r32, hi, (f32x16){});
              float mloc = -INFINITY;
#pragma unroll
              for (int t = 0; t < 4; ++t)
#pragma unroll
                  for (int r = 0; r < 16; ++r) mloc = fmaxf(mloc, s[t][r]);
              mloc = fmaxf(mloc, __shfl_xor(mloc, 32));
              const float mn = fmaxf(m, mloc); f = __builtin_amdgcn_exp2f(m - mn);
              float ls = 0.f;
#pragma unroll
              for (int t = 0; t < 4; ++t)
#pragma unroll
                  for (int r = 0; r < 16; ++r) { const float p = __builtin_amdgcn_exp2f(s[t][r] - mn); s[t][r] = p; ls += p; }
              ls += __shfl_xor(ls, 32);
              l = l * f + ls; m = mn; }
            { MIX_LANES();
              MIX_BAR();
              if (st < 3) write_k(R0, L0, false, tid); else write_g(R0, L0, vgb, 0, tid);
              load_q4(qf, PROJ + PMQ_OFF + (size_t)(2 * (st < 3 ? ((st + 1) >> 1) : hp) + wh) * MT * 64 + qoff);
              load_half(R0, tile_src(j + 4), tid);
              if (half == 1) { o[0] *= f; o[1] *= f; }
              const LAS unsigned char* Vt = L1 + wh * X_VH;
#pragma unroll
              for (int t = 0; t < 4; ++t) pv_block(o, s[t], Vt, X_VSTR, 32 * t, lane);
              if (half == 1) attn_out(o, __builtin_amdgcn_rcpf(l), stg, zv, Y + wrow0 * D_MODEL + 768 + h * 64, lane); }
        }
    }
#pragma unroll 1
    for (int gp = 0; gp < 2; ++gp) {
        const int g = 2 * gp + wh, nks = 2 * rb + 2, j = 12 + 2 * gp;
        f32x16 acc[4] = {}; u32x4 uv[8], zv[8]; bf16x8 af[8];
        { MIX_LANES(); (void)qoff;
          const bf16_t* wrow = WSP + ((size_t)(g * 128 + 32 * rb + r32)) * 128 + 8 * hi;
#pragma unroll
          for (int ks = 0; ks < 8; ++ks) af[ks] = *(const bf16x8*)(wrow + 16 * ks);
          MIX_BAR();
          write_g(R1, L1, vgb, gp, tid);
#pragma unroll
          for (int i = 0; i < 8; ++i) { const size_t row = wrow0 + i * 4 + (lane >> 4); const int ch = lane & 15;
              uv[i] = __builtin_nontemporal_load((const u32x4*)(PROJ + PU_OFF + (size_t)g * MT * 128 + row * 128 + ch * 8));
              zv[i] = __builtin_nontemporal_load((const u32x4*)(PROJ + PZ_OFF + (size_t)(2 * g + (ch >> 3)) * MT * 64 + row * 64 + (ch & 7) * 8)); }
          load_half(R1, tile_src(j + 3), tid);
          const LAS unsigned char* tb = L0 + wh * G_GRP + (8 * hi + ((lane >> 2) & 3)) * 64 + ((lane >> 4) & 1) * 32 + (lane & 3) * 8;
#pragma unroll
          for (int ks = 0; ks < 4; ++ks) if (ks < nks) {
#pragma unroll
              for (int cb = 0; cb < 4; ++cb) {
                  const s16x4 lo = vtr(tb + cb * G_CSTR + ks * 1024), hi4 = vtr(tb + cb * G_CSTR + ks * 1024 + 256);
                  const bf16x8 bfv = {lo[0], lo[1], lo[2], lo[3], hi4[0], hi4[1], hi4[2], hi4[3]};
                  acc[cb] = __builtin_amdgcn_mfma_f32_32x32x16_bf16(bfv, af[ks], acc[cb], 0, 0, 0);
              }
          } }
        { MIX_LANES(); (void)qoff;
          MIX_BAR();
          if (gp == 0) write_g(R0, L0, vgb, 1, tid);
          load_half(R0, tile_src(j + 4), tid);
          const LAS unsigned char* tb = L1 + wh * G_GRP + (8 * hi + ((lane >> 2) & 3)) * 64 + ((lane >> 4) & 1) * 32 + (lane & 3) * 8;
#pragma unroll
          for (int ks = 4; ks < 8; ++ks) if (ks < nks) {
#pragma unroll
              for (int cb = 0; cb < 4; ++cb) {
                  const s16x4 lo = vtr(tb + cb * G_CSTR + (ks - 4) * 1024), hi4 = vtr(tb + cb * G_CSTR + (ks - 4) * 1024 + 256);
                  const bf16x8 bfv = {lo[0], lo[1], lo[2], lo[3], hi4[0], hi4[1], hi4[2], hi4[3]};
                  acc[cb] = __builtin_amdgcn_mfma_f32_32x32x16_bf16(bfv, af[ks], acc[cb], 0, 0, 0);
              }
          }
          const float bs = bstab[g * 128 + 32 * rb + r32];
          LAS unsigned char* wr = stg + r32 * 256 + hi * 8; const int sw = r32 & 15;
#pragma unroll
          for (int cb = 0; cb < 4; ++cb)
#pragma unroll
              for (int rq = 0; rq < 4; ++rq) { u32x2 w; w[0] = cvtpk(acc[cb][4 * rq] + bs, acc[cb][4 * rq + 1] + bs); w[1] = cvtpk(acc[cb][4 * rq + 2] + bs, acc[cb][4 * rq + 3] + bs);
                  *(LAS u32x2*)(wr + (((cb * 4 + rq) ^ sw) << 4)) = w; }
          LDS_WAIT();
#pragma unroll
          for (int i = 0; i < 8; ++i) { const int row = i * 4 + (lane >> 4), ch = lane & 15;
              const u32x4 sv = *(const LAS u32x4*)(stg + row * 256 + ((ch ^ (row & 15)) << 4));
              *(u32x4*)(Y + (wrow0 + row) * D_MODEL + g * 128 + ch * 8) = mul8x3(sv, uv[i], zv[i]); }
          LDS_WAIT(); }
    }
    { MIX_BAR(); }
#undef MIX_LANES
#undef MIX_BAR
}
}

__global__ void __launch_bounds__(NWAVES * 64, 2) hymba_fwd(Args args) {
    extern __shared__ __attribute__((aligned(16))) unsigned char lds_raw[];
    LAS unsigned char* lds = (LAS unsigned char*)lds_raw;
    volatile LAS unsigned* MISC = (volatile LAS unsigned*)(lds + MISC_OFF);
    const int tid = threadIdx.x, lane = tid & 63, wave = __builtin_amdgcn_readfirstlane(tid >> 6);
    const int G = gridDim.x; const int bx = blockIdx.x; const int vcu = (G % 8 == 0) ? (bx % 8) * (G / 8) + bx / 8 : bx;
    unsigned char* ws = args.ws;
    unsigned* ctl = (unsigned*)(ws + WS_CTL);
    bf16_t* WIN_T = (bf16_t*)(ws + WS_WIN); bf16_t* WOUT_T = (bf16_t*)(ws + WS_WOUT); bf16_t* WSP = (bf16_t*)(ws + WS_WSP); float* SSP = (float*)(ws + WS_SSP);
    bf16_t* XN = (bf16_t*)(ws + WS_XN); bf16_t* PROJ = (bf16_t*)(ws + WS_PROJ); bf16_t* MKV = (bf16_t*)(ws + WS_MKV); bf16_t* Y = (bf16_t*)(ws + WS_Y); bf16_t* O = (bf16_t*)(ws + WS_O);
    for (int u = tid; u < (LDS_BYTES - LDSCTL_OFF) / 4; u += NWAVES * 64) ((LAS unsigned*)(lds + LDSCTL_OFF))[u] = 0u;
    __syncthreads();
    const int NG = (G == 256) ? 2 : 1, Gg = G / NG, grp = bx / Gg, cg = bx - grp * Gg;
    const int vcug = (Gg % 8 == 0) ? (cg % 8) * (Gg / 8) + cg / 8 : cg;
    const int MH = M_TOK / NG, MMH = M_MEM / NG, row_base = grp * MH, pm_base = row_base / 256;
    XcdBarrier barG = xcd_barrier_post(ctl + CW_BAR, MISC + 8, (unsigned)G);
    XcdBarrier barH = barG;
    if (NG == 2) barH = xcd_barrier_post(ctl + CW_BAR + (1 + grp) * XCD_BAR_WORDS, MISC + 10, (unsigned)Gg);
    const int gw = vcu * NWAVES + wave, NGW = G * NWAVES, gwg = vcug * NWAVES + wave, NGWg = Gg * NWAVES;

    {
        rms_rows_to_bf16<4>(args.x, args.g_pre, XN, gw, MH, NGW, lane);
        rms_rows_to_bf16<2>(args.mem, args.g_mem, XN + (size_t)M_TOK * D_MODEL, gw, M_MEM, NGW, lane);
        LAS float* scr = (LAS float*)(lds + wave * 16384);
        constexpr int I_IN = (D_MODEL / 64) * (IN_WIDTH / 32), I_MKV = (D_MODEL / 64) * (MKV_W / 32), I_OUT = (D_MODEL / 64) * (D_MODEL / 32);
        for (int it = NGW - 1 - gw; it < I_IN + I_MKV + I_OUT; it += NGW) {
            int r = it;
            if (r < I_IN) { p0_transpose_item(args.w_in, D_MODEL, IN_WIDTH, WIN_T, 0, scr, r, lane); continue; } r -= I_IN;
            if (r < I_MKV) { p0_transpose_item(args.w_mkv, D_MODEL, MKV_W, WIN_T, IN_WIDTH, scr, r, lane); continue; } r -= I_MKV;
            p0_transpose_item(args.w_out, D_MODEL, D_MODEL, WOUT_T, 0, scr, r, lane);
        }
        for (int e = bx * 512 + tid; e < 4 * 128 * 128; e += G * 512) { const int s = e & 127, t = (e >> 7) & 127; WSP[e] = (bf16_t)f2bf(s <= t ? args.wsp[e] : 0.f); }
        xcd_barrier(barG);
    }
    if (grp == 1) {
        rms_rows_to_bf16<4>(args.x + (size_t)row_base * D_MODEL, args.g_pre, XN + (size_t)row_base * D_MODEL, gwg, MH, NGWg, lane);
        xcd_barrier(barH);
    }
    {
        pg8::Gemm g{XN + (size_t)row_base * D_MODEL, WIN_T, MH, IN_WIDTH + MKV_W, D_MODEL};
        pg8::MergedOrder S; S.S.init(MH, IN_WIDTH, Gg, cg, NG == 2 ? 4 : 8); S.eM = MMH / 256; S.eN = MKV_W / 256; S.ePm0 = (M_TOK + grp * MMH - row_base) / 256;
        EpiProj E{PROJ, MKV, pm_base, S.ePm0, grp * (BATCH / NG)};
        pg8::gemm_phase<EpiProj, pg8::MergedOrder, true, true>(lds, g, S, E);
        xcd_barrier(barH);
    }
    {
        for (int idx = tid; idx < 5 * 192; idx += NWAVES * 64) { const int h = idx / 192, dist = 159 - (idx % 192);
            ((LAS float*)(lds + mix::BIAS_OFF))[idx] = (h < 4 && dist >= 0 && dist < 128) ? args.relb[t5_bucket(dist) * 4 + h] * LOG2E : -INFINITY; }
        if (tid < 4) ((LAS float*)(lds + mix::BIAS_OFF))[5 * 192 + tid] = args.sinks[tid] * LOG2E;
        ((LAS float*)(lds + mix::BSP_OFF))[tid] = args.bsp[tid];
        ((LAS float*)(lds + mix::VGB_OFF))[tid] = args.vg[tid]; ((LAS float*)(lds + mix::VGB_OFF))[512 + tid] = args.vb[tid];
        __syncthreads();
        const int nu = BATCH * (SEQ / CHUNK) / NG;
        for (int u = vcug; u < nu; u += Gg) mix::mix_unit(grp * nu + u, lds, PROJ, MKV, WSP, Y, tid, wave);
        xcd_barrier(barH);
    }
    {
        pg8::Gemm g{Y + (size_t)row_base * D_MODEL, WOUT_T, MH, D_MODEL, D_MODEL};
        pg8::StaticOrder S; S.init(MH, D_MODEL, Gg, cg, NG == 2 ? 4 : 8);
        EpiOut E{O, SSP, pm_base};
        pg8::gemm_phase<EpiOut, pg8::StaticOrder, true, true>(lds, g, S, E);
        xcd_barrier(barH);
    }
    {
        const GAS f32x4* gp = (const GAS f32x4*)args.g_post + lane;
        f32x4 gg[4];
#pragma unroll
        for (int j = 0; j < 4; ++j) gg[j] = gp[64 * j];
        constexpr int NB = 4;
        const int m_end = row_base + MH;
        for (int m0 = row_base + gwg; m0 < m_end; m0 += NB * NGWg) {
            v2u ov[NB][4]; f32x4 xv[NB][4]; float ssp[NB];
#pragma unroll
            for (int i = 0; i < NB; ++i) { const int m = (m0 + i * NGWg < m_end) ? m0 + i * NGWg : m0;
                const GAS v2u* orow = (const GAS v2u*)(O + (size_t)m * D_MODEL) + lane; const GAS f32x4* xr = (const GAS f32x4*)(args.x + (size_t)m * D_MODEL) + lane;
#pragma unroll
                for (int j = 0; j < 4; ++j) { ov[i][j] = __builtin_nontemporal_load(&orow[64 * j]); xv[i][j] = __builtin_nontemporal_load(&xr[64 * j]); }
                ssp[i] = SSP[(size_t)m * 16 + (lane & 15)]; }
#pragma unroll
            for (int i = 0; i < NB; ++i) { const int m = m0 + i * NGWg;
                const float r = rsqrtf(wave_sum(ssp[i]) * 0.25f * (1.f / D_MODEL) + EPS);
                if (m < m_end) {
                    GAS f32x4* outr = (GAS f32x4*)(args.out + (size_t)m * D_MODEL) + lane;
#pragma unroll
                    for (int j = 0; j < 4; ++j) { f32x4 o;
                        o.x = xv[i][j].x + bflo(ov[i][j].x) * r * gg[j].x; o.y = xv[i][j].y + bfhi(ov[i][j].x) * r * gg[j].y; o.z = xv[i][j].z + bflo(ov[i][j].y) * r * gg[j].z; o.w = xv[i][j].w + bfhi(ov[i][j].y) * r * gg[j].w;
                        __builtin_nontemporal_store(o, &outr[64 * j]); }
                }
            }
        }
    }
}

extern "C" void kernel_launch(void* const* d_in, const int* in_sizes, int n_in, void* d_out, int out_size, void* d_ws, size_t ws_size, hipStream_t stream) {
    static int grid = 0;
    if (grid == 0) {
        if (n_in != 14 || in_sizes[0] != M_TOK * D_MODEL || out_size != M_TOK * D_MODEL || ws_size < WS_END) { fprintf(stderr, "kernel_launch: unexpected shapes (n_in %d, ws %zu)\n", n_in, ws_size); grid = -1; return; }
        int dev = 0, cus = 0, per_cu = 0;
        if (hipGetDevice(&dev) != hipSuccess || hipDeviceGetAttribute(&cus, hipDeviceAttributeMultiprocessorCount, dev) != hipSuccess) { grid = -1; return; }
        if (hipFuncSetAttribute((const void*)hymba_fwd, hipFuncAttributeMaxDynamicSharedMemorySize, LDS_BYTES) != hipSuccess) { fprintf(stderr, "kernel_launch: hipFuncSetAttribute failed\n"); grid = -1; return; }
        if (hipOccupancyMaxActiveBlocksPerMultiprocessor(&per_cu, (const void*)hymba_fwd, NWAVES * 64, LDS_BYTES) != hipSuccess || per_cu < 1) { fprintf(stderr, "kernel_launch: occupancy query says %d blocks/CU\n", per_cu); per_cu = 1; }
        (void)hipGetLastError();
        grid = cus;
    }
    if (grid < 0) return;
    (void)hipMemsetAsync((char*)d_ws + WS_CTL, 0, CTL_ZERO_BYTES, stream);
    Args a{};
    a.x = (const float*)d_in[0]; a.mem = (const float*)d_in[1]; a.g_pre = (const float*)d_in[2]; a.g_post = (const float*)d_in[3]; a.g_mem = (const float*)d_in[4];
    a.w_in = (const float*)d_in[5]; a.w_mkv = (const float*)d_in[6]; a.vg = (const float*)d_in[7]; a.vb = (const float*)d_in[8]; a.wsp = (const float*)d_in[9]; a.bsp = (const float*)d_in[10];
    a.sinks = (const float*)d_in[11]; a.relb = (const float*)d_in[12]; a.w_out = (const float*)d_in[13];
    a.out = (float*)d_out; a.ws = (unsigned char*)d_ws;
    hipLaunchKernelGGL(hymba_fwd, dim3(grid), dim3(NWAVES * 64), LDS_BYTES, stream, a);
}
```

```cpp
#include <hip/hip_runtime.h>
#include <cstdio>
#include <cstdint>

namespace pg8 {
#define PG8_LAS __attribute__((address_space(3)))
typedef unsigned short bf16_t;
typedef short bf16x8 __attribute__((ext_vector_type(8)));
typedef float f32x4 __attribute__((ext_vector_type(4)));
typedef unsigned u32x4 __attribute__((ext_vector_type(4)));
constexpr int BM = 256, BK = 64, HALF = 128, HTB = HALF * BK * 2, STAGE_BYTES = 8 * HTB, NXCD = 8, WGM = 8;

__host__ __device__ __forceinline__ int lds_byte(int r, int c) { const int st = (r >> 4) * 2 + (c >> 5), rr = r & 15, cc = c & 31, ob = rr * 64 + cc * 2; return st * 1024 + (ob ^ (((ob >> 9) & 1) << 5)); }
__host__ __device__ __forceinline__ void stage_rc(int b, int& R, int& C) { const int st = b / 1024, sb = b % 1024, swz = sb ^ (((sb >> 9) & 1) << 5); R = (st >> 1) * 16 + swz / 64; C = (st & 1) * 32 + (swz % 64) / 2; }
__host__ __device__ __forceinline__ int perm32(int rho) { const int n = rho >> 4, i = rho & 15; return 8 * (i >> 2) + 4 * n + (i & 3); }

struct Unit { int pm, pn; };
struct Gemm { const bf16_t* A; const bf16_t* Bt; int M, N, K; };

struct StaticOrder {
    int nM, nN, nwg, G, c, wgm;
    __host__ __device__ void init(int M, int N, int G_, int c_, int wgm_ = WGM) { nM = M / BM; nN = N / BM; nwg = nM * nN; G = G_; c = c_; wgm = wgm_; }
    __host__ __device__ void map(int wgid, Unit& u) const {
        { const int q = nwg / NXCD, r = nwg % NXCD, xcd = wgid % NXCD, off = wgid / NXCD; wgid = (xcd < r ? xcd * (q + 1) : r * (q + 1) + (xcd - r) * q) + off; }
        const int nig = wgm * nN, gid = wgid / nig, fm = gid * wgm, gsz = (nM - fm) < wgm ? (nM - fm) : wgm;
        u.pm = fm + ((wgid % nig) % gsz); u.pn = (wgid % nig) / gsz;
    }
    __host__ __device__ bool next(int i, Unit& u) const { const long L = (long)i * G + c; if (L >= nwg) return false; map((int)L, u); return true; }
    __device__ __forceinline__ void a_ready(const Unit&) const {}
    __device__ __forceinline__ void done(const Unit&) const {}
};
struct MergedOrder {
    StaticOrder S; int eM, eN, ePm0;
    __host__ __device__ bool next(int i, Unit& u) const {
        const int G = S.G, c = S.c, nfull = S.nwg / G, rem = S.nwg - nfull * G, nx = eM * eN;
        if (nfull < 1 || rem + 2 * nx > G) {
            if (S.next(i, u)) return true;
            const long L = (long)i * G + c - S.nwg; if (L >= (long)nx) return false;
            u.pm = ePm0 + (int)(L / eN); u.pn = S.nN + (int)(L % eN); return true;
        }
        if (c >= rem && c < rem + nx) {
            if (i < nfull - 1) return S.next(i, u);
            if (i > nfull - 1) return false;
            const int e = c - rem; u.pm = ePm0 + e / eN; u.pn = S.nN + e % eN; return true;
        }
        if (c >= rem + nx && c < rem + 2 * nx) {
            if (i < nfull) return S.next(i, u);
            if (i > nfull) return false;
            S.map((nfull - 1) * G + (c - nx), u); return true;
        }
        return S.next(i, u);
    }
    __device__ __forceinline__ void a_ready(const Unit&) const {}
    __device__ __forceinline__ void done(const Unit&) const {}
};

__device__ __forceinline__ unsigned cvt_pk_bf16(float lo, float hi) { unsigned r; asm volatile("v_cvt_pk_bf16_f32 %0, %1, %2" : "=v"(r) : "v"(lo), "v"(hi)); return r; }

template <class Epi, class Sched, bool ALIGN_EPI = false, bool SP2 = false>
__device__ __forceinline__ void gemm_phase(PG8_LAS unsigned char* lds, const Gemm g, const Sched& S, const Epi& E) {
    const int tid = threadIdx.x, wid = __builtin_amdgcn_readfirstlane(tid >> 6), lane = tid & 63, wr = wid >> 2, wc = wid & 3, fr = lane & 15, fq = lane >> 4;
    const int K = g.K, nt = K / BK;
    unsigned voffA[2], voffB[2];
#pragma unroll
    for (int i = 0; i < 2; ++i) { int R, C; stage_rc(tid * 16 + i * 8192, R, C); const int Rb = Epi::PERM ? ((R & ~31) + perm32(R & 31)) : R;
        voffA[i] = (unsigned)(R * K + C) * 2u; voffB[i] = (unsigned)(Rb * K + C) * 2u; }
    const size_t kstep = (size_t)(BK * 2);
    const size_t hstep = (size_t)HALF * K * 2;
    const size_t tstep = 2 * hstep;
    const unsigned ldsw = (unsigned)wid * 1024u;
    const int aoff = lds_byte(wr * 64 + fr, fq * 8), boff = lds_byte(wc * 32 + fr, fq * 8);
#define PG8_SA(b, h) (((b) * 2 + (h)) * HTB)
#define PG8_SB(b, h) ((4 + (b) * 2 + (h)) * HTB)
#define PG8_STAGE(bufoff, gbase, voff) do { _Pragma("unroll") for (int _i = 0; _i < 2; ++_i) \
        __builtin_amdgcn_global_load_lds((const unsigned*)((const char*)(gbase) + (voff)[_i]), (PG8_LAS unsigned*)(lds + (bufoff) + ldsw + _i * 8192), 16, 0, 0); } while (0)
#define PG8_LDA(dst, b, h) do { _Pragma("unroll") for (int m = 0; m < 4; ++m) _Pragma("unroll") for (int k = 0; k < 2; ++k) dst[m][k] = *(const PG8_LAS bf16x8*)(lds + PG8_SA(b, h) + aoff + m * 2048 + k * 1024); } while (0)
#define PG8_LDB(dst, b, h) do { _Pragma("unroll") for (int n = 0; n < 2; ++n) _Pragma("unroll") for (int k = 0; k < 2; ++k) dst[n][k] = *(const PG8_LAS bf16x8*)(lds + PG8_SB(b, h) + boff + n * 2048 + k * 1024); } while (0)
#define PG8_MMA(ai, bj, At, Bt) do { __builtin_amdgcn_s_setprio(1); _Pragma("unroll") for (int m = 0; m < 4; ++m) _Pragma("unroll") for (int n = 0; n < 2; ++n) _Pragma("unroll") for (int k = 0; k < 2; ++k) \
        acc[ai][bj][m][n] = __builtin_amdgcn_mfma_f32_16x16x32_bf16(Bt[n][k], At[m][k], acc[ai][bj][m][n], 0, 0, 0); __builtin_amdgcn_s_setprio(0); } while (0)
#define PG8_WAIT_V(n) asm volatile("s_waitcnt vmcnt(" #n ")" ::: "memory")
#define PG8_WAIT_L(n) asm volatile("s_waitcnt lgkmcnt(" #n ")" ::: "memory")
#define PG8_BAR __builtin_amdgcn_s_barrier()
#define PG8_SCHED __builtin_amdgcn_sched_barrier(0)
    Unit cur, nxt; int ui = 0;
    if (!S.next(0, cur)) return;
    f32x4 acc[2][2][4][2];
#pragma unroll
    for (int a = 0; a < 2; ++a)
#pragma unroll
        for (int b = 0; b < 2; ++b)
#pragma unroll
            for (int m = 0; m < 4; ++m)
#pragma unroll
                for (int n = 0; n < 2; ++n) acc[a][b][m][n] = (f32x4){0.f, 0.f, 0.f, 0.f};
    bf16x8 At[4][2], B0[2][2], B1[2][2];
    const char* cA = (const char*)g.A + (size_t)cur.pm * tstep; const char* cB = (const char*)g.Bt + (size_t)cur.pn * tstep;
    S.a_ready(cur);
    if constexpr (SP2) {
        PG8_STAGE(PG8_SB(0, 0), cB, voffB); PG8_STAGE(PG8_SB(0, 1), cB + hstep, voffB); PG8_STAGE(PG8_SA(0, 0), cA, voffA); PG8_STAGE(PG8_SA(0, 1), cA + hstep, voffA);
        if (wr == 1) PG8_BAR;
        PG8_WAIT_V(2); PG8_BAR;
        PG8_STAGE(PG8_SB(1, 0), cB + kstep, voffB); PG8_STAGE(PG8_SA(1, 0), cA + kstep, voffA); PG8_STAGE(PG8_SB(1, 1), cB + hstep + kstep, voffB);
        PG8_WAIT_V(6); PG8_BAR;
    } else {
        PG8_STAGE(PG8_SB(0, 0), cB, voffB); PG8_STAGE(PG8_SA(0, 0), cA, voffA); PG8_STAGE(PG8_SB(0, 1), cB + hstep, voffB); PG8_STAGE(PG8_SA(0, 1), cA + hstep, voffA);
        if (wr == 1) PG8_BAR;
        PG8_WAIT_V(4); PG8_BAR;
        PG8_STAGE(PG8_SB(1, 0), cB + kstep, voffB); PG8_STAGE(PG8_SA(1, 0), cA + kstep, voffA); PG8_STAGE(PG8_SB(1, 1), cB + hstep + kstep, voffB);
        PG8_WAIT_V(6); PG8_BAR;
    }
    for (;;) {
        const bool has_next = S.next(ui + 1, nxt);
        const char* nA = has_next ? (const char*)g.A + (size_t)nxt.pm * tstep : cA; const char* nB = has_next ? (const char*)g.Bt + (size_t)nxt.pn * tstep : cB;
        for (int t = 0; t < nt; t += 2) {
            const bool last = (t == nt - 2);
            const char* a1 = cA + (size_t)(t + 1) * kstep;
            const char* a2 = last ? nA : cA + (size_t)(t + 2) * kstep; const char* b2 = last ? nB : cB + (size_t)(t + 2) * kstep;
            const char* a3 = a2 + kstep; const char* b3 = b2 + kstep;
            if (last && has_next) S.a_ready(nxt);
            if constexpr (SP2) {
            PG8_LDB(B0, 0, 0); PG8_LDB(B1, 0, 1); PG8_SCHED; PG8_LDA(At, 0, 0); PG8_STAGE(PG8_SA(1, 1), a1 + hstep, voffA);
            PG8_WAIT_V(8); PG8_WAIT_L(0); PG8_BAR; PG8_MMA(0, 0, At, B0); PG8_MMA(0, 1, At, B1); PG8_BAR; PG8_SCHED;
            PG8_LDA(At, 0, 1); PG8_STAGE(PG8_SB(0, 0), b2, voffB); PG8_STAGE(PG8_SB(0, 1), b2 + hstep, voffB); PG8_STAGE(PG8_SA(0, 0), a2, voffA);
            PG8_WAIT_V(8); PG8_WAIT_L(0); PG8_BAR; PG8_MMA(1, 0, At, B0); PG8_MMA(1, 1, At, B1); PG8_BAR; PG8_SCHED;
            PG8_LDB(B0, 1, 0); PG8_LDB(B1, 1, 1); PG8_SCHED; PG8_LDA(At, 1, 0); PG8_STAGE(PG8_SA(0, 1), a2 + hstep, voffA);
            PG8_WAIT_V(8); PG8_WAIT_L(0); PG8_BAR; PG8_MMA(0, 0, At, B0); PG8_MMA(0, 1, At, B1); PG8_BAR; PG8_SCHED;
            PG8_LDA(At, 1, 1); PG8_STAGE(PG8_SB(1, 0), b3, voffB); PG8_STAGE(PG8_SB(1, 1), b3 + hstep, voffB); PG8_STAGE(PG8_SA(1, 0), a3, voffA);
            PG8_WAIT_V(8); PG8_WAIT_L(0); PG8_BAR; PG8_MMA(1, 0, At, B0); PG8_MMA(1, 1, At, B1); PG8_BAR; PG8_SCHED;
            } else {
            PG8_LDB(B0, 0, 0); PG8_SCHED; PG8_LDA(At, 0, 0); PG8_STAGE(PG8_SA(1, 1), a1 + hstep, voffA);
            PG8_WAIT_L(8); PG8_BAR; PG8_WAIT_L(0); PG8_MMA(0, 0, At, B0); PG8_BAR; PG8_SCHED;
            PG8_LDB(B1, 0, 1); PG8_STAGE(PG8_SB(0, 0), b2, voffB);
            PG8_BAR; PG8_WAIT_L(0); PG8_MMA(0, 1, At, B1); PG8_BAR;
            PG8_LDA(At, 0, 1); PG8_STAGE(PG8_SA(0, 0), a2, voffA);
            PG8_BAR; PG8_WAIT_L(0); PG8_MMA(1, 0, At, B0); PG8_BAR; PG8_SCHED;
            PG8_STAGE(PG8_SB(0, 1), b2 + hstep, voffB);
            PG8_WAIT_V(6); PG8_BAR; PG8_MMA(1, 1, At, B1); PG8_BAR;
            PG8_LDB(B0, 1, 0); PG8_SCHED; PG8_LDA(At, 1, 0); PG8_STAGE(PG8_SA(0, 1), a2 + hstep, voffA);
            PG8_WAIT_L(8); PG8_BAR; PG8_WAIT_L(0); PG8_MMA(0, 0, At, B0); PG8_BAR; PG8_SCHED;
            PG8_LDB(B1, 1, 1); PG8_STAGE(PG8_SB(1, 0), b3, voffB);
            PG8_BAR; PG8_WAIT_L(0); PG8_MMA(0, 1, At, B1); PG8_BAR;
            PG8_LDA(At, 1, 1); PG8_STAGE(PG8_SA(1, 0), a3, voffA);
            PG8_BAR; PG8_WAIT_L(0); PG8_MMA(1, 0, At, B0); PG8_BAR; PG8_SCHED;
            PG8_STAGE(PG8_SB(1, 1), b3 + hstep, voffB);
            PG8_WAIT_V(6); PG8_BAR; PG8_MMA(1, 1, At, B1); PG8_BAR;
            }
        }
        if constexpr (ALIGN_EPI) { if (wr == 0) PG8_BAR; }
        E(acc, cur, wr, wc, fr, fq); S.done(cur);
        if (!has_next) break;
#pragma unroll
        for (int a = 0; a < 2; ++a)
#pragma unroll
            for (int b = 0; b < 2; ++b)
#pragma unroll
                for (int m = 0; m < 4; ++m)
#pragma unroll
                    for (int n = 0; n < 2; ++n) acc[a][b][m][n] = (f32x4){0.f, 0.f, 0.f, 0.f};
        cur = nxt; cA = nA; cB = nB; ++ui;
        if constexpr (ALIGN_EPI) { if (wr == 1) PG8_BAR; }
    }
    PG8_WAIT_V(0);
    if constexpr (!ALIGN_EPI) { if (wr == 0) PG8_BAR; }
    PG8_BAR;
#undef PG8_SA
#undef PG8_SB
#undef PG8_STAGE
#undef PG8_LDA
#undef PG8_LDB
#undef PG8_MMA
#undef PG8_WAIT_V
#undef PG8_WAIT_L
#undef PG8_BAR
#undef PG8_SCHED
}
}

typedef unsigned short bf16_t;
constexpr int D_MODEL = 1024, BATCH = 16, SEQ = 2048, MEM_LEN = 256, HD = 64, CHUNK = 128;
constexpr int M_TOK = BATCH * SEQ, M_MEM = BATCH * MEM_LEN;
constexpr int A_WIDTH = 512, IN_WIDTH = 2816, MKV_W = 512;
constexpr int C_U = 0, C_V = 512, C_SQ = 1024, C_SK = 1280, C_SV = 1408, C_MQ = 1536, C_Z = 1792;
constexpr size_t MT = (size_t)BATCH * SEQ;
constexpr size_t PU_OFF = 0, PV_OFF = PU_OFF + 4 * MT * 128, PQ_OFF = PV_OFF + 4 * MT * 128, PK_OFF = PQ_OFF + 4 * MT * 64, PVV_OFF = PK_OFF + 2 * MT * 64, PMQ_OFF = PVV_OFF + 2 * MT * 64, PZ_OFF = PMQ_OFF + 4 * MT * 64;
static_assert(PZ_OFF + 16 * MT * 64 == MT * 2816, "blocked PROJ layout covers exactly IN_WIDTH columns");
constexpr size_t MV_OFF = (size_t)BATCH * 4 * MEM_LEN * 64;
constexpr float EPS = 1e-6f;
constexpr float LOG2E = 1.4426950408889634f;
constexpr float QSCALE = 0.125f * LOG2E;
constexpr int NWAVES = 8;

constexpr size_t MiB = 1u << 20;
constexpr size_t WS_CTL = 0, CTL_ZERO_BYTES = 64 * 1024;
constexpr size_t WS_WIN = 2 * MiB;
constexpr size_t WS_WOUT = 10 * MiB;
constexpr size_t WS_WSP = 12 * MiB;
constexpr size_t WS_SSP = 13 * MiB;
constexpr size_t WS_XN = 16 * MiB;
constexpr size_t WS_PROJ = 96 * MiB;
constexpr size_t WS_MKV = 272 * MiB;
constexpr size_t WS_Y = 280 * MiB;
constexpr size_t WS_O = 344 * MiB;
constexpr size_t WS_END = 408 * MiB;
constexpr int CW_BAR = 1024;

constexpr int RING_BYTES = 131072, LDSCTL_OFF = 138240, MISC_OFF = LDSCTL_OFF + 320, LDS_BYTES = 147456;

#define GAS __attribute__((address_space(1)))
#define LAS __attribute__((address_space(3)))
typedef unsigned v4u __attribute__((ext_vector_type(4)));
typedef unsigned v2u __attribute__((ext_vector_type(2)));
typedef float f32x4 __attribute__((ext_vector_type(4)));
#define LDS_WAIT() asm volatile("s_waitcnt lgkmcnt(0)" ::: "memory")
#define VM_WAIT() asm volatile("s_waitcnt vmcnt(0)" ::: "memory")
__device__ __forceinline__ float bf2f(bf16_t v) { return __builtin_bit_cast(float, (unsigned)v << 16); }
__device__ __forceinline__ unsigned f2bf(float f) { unsigned u = __builtin_bit_cast(unsigned, f); return (u + 0x7fffu + ((u >> 16) & 1u)) >> 16; }
__device__ __forceinline__ unsigned pk2(float lo, float hi) { return f2bf(lo) | (f2bf(hi) << 16); }
__device__ __forceinline__ float bflo(unsigned w) { return __builtin_bit_cast(float, w << 16); }
__device__ __forceinline__ float bfhi(unsigned w) { return __builtin_bit_cast(float, w & 0xffff0000u); }
__device__ __forceinline__ float fast_sigmoid_mul(float x, float t) { return x * __builtin_amdgcn_rcpf(1.f + __builtin_amdgcn_exp2f(-t * LOG2E)); }
__device__ __forceinline__ float gelu_tanh(float x) { return fast_sigmoid_mul(x, 1.5957691216057308f * (x + 0.044715f * x * x * x)); }
__device__ __forceinline__ float silu(float x) { return fast_sigmoid_mul(x, x); }
typedef float f32x2 __attribute__((ext_vector_type(2)));
__device__ __forceinline__ f32x2 sigmoid_mul_pk(f32x2 x, f32x2 tneg) {
    f32x2 e; e.x = __builtin_amdgcn_exp2f(tneg.x); e.y = __builtin_amdgcn_exp2f(tneg.y);
    const f32x2 d = e + 1.0f; f32x2 r; r.x = __builtin_amdgcn_rcpf(d.x); r.y = __builtin_amdgcn_rcpf(d.y);
    return x * r;
}
__device__ __forceinline__ f32x2 gelu_tanh_pk(f32x2 x) { const f32x2 x2 = x * x; const f32x2 q = x2 * (-0.044715f * 1.5957691216057308f * LOG2E) + (-1.5957691216057308f * LOG2E); return sigmoid_mul_pk(x, x * q); }
__device__ __forceinline__ f32x2 silu_pk(f32x2 x) { return sigmoid_mul_pk(x, x * (-LOG2E)); }
__device__ __forceinline__ float wave_sum(float v) {
#pragma unroll
    for (int o = 1; o < 64; o <<= 1) v += __shfl_xor(v, o);
    return v;
}

#define XB_TMO      128
#define XB_XCNT(j)  (256  + 64 * (j))
#define XB_XSUB(j)  (1280 + 64 * (j))
#define XB_XGEN(j)  (2304 + 64 * (j))
#define XB_TOP      3328
#define XB_TOPGEN   3392
#define XCD_BAR_WORDS 3456
#define XB_SPIN_CAP (1u << 18)
__device__ __forceinline__ unsigned xb_ld(unsigned* p)              { return __hip_atomic_load(p, __ATOMIC_RELAXED, __HIP_MEMORY_SCOPE_AGENT); }
__device__ __forceinline__ unsigned xb_add(unsigned* p, unsigned v) { return __hip_atomic_fetch_add(p, v, __ATOMIC_RELAXED, __HIP_MEMORY_SCOPE_AGENT); }
__device__ __forceinline__ unsigned xb_xcc_id() { return (unsigned)__builtin_amdgcn_s_getreg((3 << 11) | 20) & 0xFu; }
#define XB_SPIN(cond, bar) do { unsigned _sp = 0; while (cond) { __builtin_amdgcn_s_sleep(1); \
    if ((++_sp & 255u) == 0u) { if (xb_ld(&(bar)[XB_TMO])) break; if (_sp > XB_SPIN_CAP) { atomicAdd(&(bar)[XB_TMO], 1u); break; } } } } while (0)
struct XcdBarrier { unsigned* bar; unsigned x; volatile LAS unsigned* st; unsigned n; };
__device__ __forceinline__ XcdBarrier xcd_barrier_post(unsigned* bar, volatile LAS unsigned* st, unsigned n) {
    XcdBarrier b; b.bar = bar; b.x = xb_xcc_id(); b.st = st; b.n = n;
    if (threadIdx.x == 0) (void)xb_add(&bar[XB_XCNT(b.x)], 1u);
    return b;
}
__device__ __forceinline__ void xcd_barrier_complete(unsigned* bar, unsigned x, unsigned G, unsigned& nloc, unsigned& nx) {
    unsigned sum, cnt, mine, sp = 0u;
    for (;;) {
        sum = 0u; cnt = 0u; mine = 0u;
#pragma unroll
        for (unsigned j = 0; j < 16; ++j) { const unsigned c = xb_ld(&bar[XB_XCNT(j)]); sum += c; cnt += (c > 0u) ? 1u : 0u; mine = (j == x) ? c : mine; }
        if (sum == G) break;
        __builtin_amdgcn_s_sleep(1);
        if ((++sp & 255u) == 0u) { if (xb_ld(&bar[XB_TMO])) break; if (sp > XB_SPIN_CAP) { atomicAdd(&bar[XB_TMO], 1u); break; } }
    }
    nloc = mine > 0u ? mine : 1u; nx = cnt > 0u ? cnt : 1u;
}
__device__ __forceinline__ void xcd_barrier(const XcdBarrier& b) {
    asm volatile("s_waitcnt vmcnt(0)" ::: "memory");
    __syncthreads();
    if (threadIdx.x == 0) {
        unsigned* bar = b.bar;
        __builtin_amdgcn_s_waitcnt(0);
        unsigned nloc = b.st[0], nx = b.st[1];
        if (nloc == 0u) { xcd_barrier_complete(bar, b.x, b.n, nloc, nx); b.st[0] = nloc; b.st[1] = nx; }
        const unsigned old = xb_add(&bar[XB_XSUB(b.x)], 1u);
        const unsigned gen = old / nloc;
        if (old + 1u == (gen + 1u) * nloc) {
            __builtin_amdgcn_fence(__ATOMIC_RELEASE, "agent");
            asm volatile("s_waitcnt vmcnt(0)" ::: "memory");
            const unsigned og = xb_add(&bar[XB_TOP], 1u);
            const unsigned tg = og / nx;
            if (og + 1u == (tg + 1u) * nx) xb_add(&bar[XB_TOPGEN], 1u);
            else XB_SPIN(xb_ld(&bar[XB_TOPGEN]) == tg, bar);
            __builtin_amdgcn_fence(__ATOMIC_ACQUIRE, "agent");
            xb_add(&bar[XB_XGEN(b.x)], 1u);
            asm volatile("s_waitcnt vmcnt(0)" ::: "memory");
        } else {
            XB_SPIN(xb_ld(&bar[XB_XGEN(b.x)]) == gen, bar);
            __builtin_amdgcn_fence(__ATOMIC_ACQUIRE, "agent");
            asm volatile("s_waitcnt vmcnt(0)" ::: "memory");
        }
    }
    __syncthreads();
}

struct Args {
    const float *x, *mem, *g_pre, *g_post, *g_mem, *w_in, *w_mkv, *vg, *vb, *wsp, *bsp, *sinks, *relb, *w_out;
    float* out; unsigned char* ws;
};

__device__ __forceinline__ void p0_transpose_item(const float* W, int K, int N, bf16_t* WT, int row_off, LAS float* scr, int item, int lane) {
    const int nblk = N / 32, kb = item / nblk, nb = item % nblk, k0 = 64 * kb, n0 = 32 * nb;
    float wv[32];
#pragma unroll
    for (int i = 0; i < 32; ++i) wv[i] = W[(size_t)(k0 + 2 * i + (lane >> 5)) * N + n0 + (lane & 31)];
#pragma unroll
    for (int i = 0; i < 32; ++i) scr[(2 * i + (lane >> 5)) * 33 + (lane & 31)] = wv[i];
    LDS_WAIT(); asm volatile("" ::: "memory");
    const int c = lane & 7;
#pragma unroll
    for (int j = 0; j < 4; ++j) { const int n = (lane >> 3) + 8 * j; const LAS float* s = scr + (8 * c) * 33 + n;
        v4u o; o.x = pk2(s[0 * 33], s[1 * 33]); o.y = pk2(s[2 * 33], s[3 * 33]); o.z = pk2(s[4 * 33], s[5 * 33]); o.w = pk2(s[6 * 33], s[7 * 33]);
        *(GAS v4u*)(WT + (size_t)(row_off + n0 + n) * K + k0 + 8 * c) = o; }
    LDS_WAIT(); asm volatile("" ::: "memory");
}
template <int NB> __device__ __forceinline__ void rms_rows_to_bf16(const float* src, const float* g, bf16_t* dst, int m0, int m1, int step, int lane) {
    if (m0 >= m1) return;
    const int mlast = m0 + ((m1 - 1 - m0) / step) * step;
    const GAS f32x4* gr = (const GAS f32x4*)g + lane;
    f32x4 gg[4];
#pragma unroll
    for (int j = 0; j < 4; ++j) gg[j] = gr[64 * j];
    f32x4 v[NB][4], nx[NB][4];
#pragma unroll
    for (int i = 0; i < NB; ++i) { const int mr = m0 + i * step < mlast ? m0 + i * step : mlast; const GAS f32x4* xr = (const GAS f32x4*)(src + (size_t)mr * D_MODEL) + lane;
#pragma unroll
        for (int j = 0; j < 4; ++j) v[i][j] = __builtin_nontemporal_load(&xr[64 * j]); }
    for (int m = m0; m < m1; m += NB * step) {
#pragma unroll
        for (int i = 0; i < NB; ++i) { const int mn = m + (NB + i) * step, mr = mn < mlast ? mn : mlast; const GAS f32x4* xr = (const GAS f32x4*)(src + (size_t)mr * D_MODEL) + lane;
#pragma unroll
            for (int j = 0; j < 4; ++j) nx[i][j] = __builtin_nontemporal_load(&xr[64 * j]); }
#pragma unroll
        for (int i = 0; i < NB; ++i) {
            const int mi = m + i * step;
            float s = 0.f;
#pragma unroll
            for (int j = 0; j < 4; ++j) s += (v[i][j].x * v[i][j].x + v[i][j].y * v[i][j].y) + (v[i][j].z * v[i][j].z + v[i][j].w * v[i][j].w);
            const float r = rsqrtf(wave_sum(s) * (1.f / D_MODEL) + EPS);
            if (mi < m1) {
                GAS v2u* o8 = (GAS v2u*)(dst + (size_t)mi * D_MODEL) + lane;
#pragma unroll
                for (int j = 0; j < 4; ++j) { v2u w; w.x = pk2(v[i][j].x * r * gg[j].x, v[i][j].y * r * gg[j].y); w.y = pk2(v[i][j].z * r * gg[j].z, v[i][j].w * r * gg[j].w); o8[64 * j] = w; }
            }
        }
#pragma unroll
        for (int i = 0; i < NB; ++i)
#pragma unroll
            for (int j = 0; j < 4; ++j) v[i][j] = nx[i][j];
    }
}

struct EpiProj {
    static constexpr bool PERM = true;
    bf16_t* PROJ; bf16_t* MKV; int pm_base, mem_pm0, mem_b0;
    template <int ACT> __device__ __forceinline__ void tile(const pg8::f32x4 (&acc)[2][2][4][2], bf16_t* b0, bf16_t* b1, int pitch) const {
#pragma unroll
        for (int ai = 0; ai < 2; ++ai)
#pragma unroll
            for (int m = 0; m < 4; ++m) { const size_t ro = (size_t)(ai * 128 + m * 16) * pitch;
#pragma unroll
                for (int bj = 0; bj < 2; ++bj) { f32x2 p[4];
#pragma unroll
                    for (int e = 0; e < 2; ++e) { p[e] = (f32x2){acc[ai][bj][m][0][2 * e], acc[ai][bj][m][0][2 * e + 1]}; p[2 + e] = (f32x2){acc[ai][bj][m][1][2 * e], acc[ai][bj][m][1][2 * e + 1]}; }
#pragma unroll
                    for (int e = 0; e < 4; ++e) { if (ACT == 1) p[e] = gelu_tanh_pk(p[e]); else if (ACT == 2) p[e] = p[e] * QSCALE; else if (ACT == 3) p[e] = silu_pk(p[e]); }
                    pg8::u32x4 w; w.x = pg8::cvt_pk_bf16(p[0].x, p[0].y); w.y = pg8::cvt_pk_bf16(p[1].x, p[1].y); w.z = pg8::cvt_pk_bf16(p[2].x, p[2].y); w.w = pg8::cvt_pk_bf16(p[3].x, p[3].y);
                    *(pg8::u32x4*)((bj ? b1 : b0) + ro) = w; } }
    }
    __device__ __forceinline__ void operator()(const pg8::f32x4 (&acc)[2][2][4][2], const pg8::Unit& u, int wr, int wc, int fr, int fq) const {
        const int c128 = wc * 32 + 8 * fq, c64 = (wc & 1) * 32 + 8 * fq, k64 = wc >> 1;
        if (u.pn < 11) {
            const size_t row = (size_t)(pm_base + u.pm) * 256 + wr * 64 + fr;
            if (u.pn < 4) {
                bf16_t* base = PROJ + (u.pn < 2 ? PU_OFF : PV_OFF) + (size_t)(2 * (u.pn & 1)) * MT * 128 + row * 128 + c128;
                tile<1>(acc, base, base + MT * 128, 128);
            } else if (u.pn == 4 || u.pn == 6) {
                bf16_t* base = PROJ + (u.pn == 4 ? PQ_OFF : PMQ_OFF) + (size_t)k64 * MT * 64 + row * 64 + c64;
                tile<2>(acc, base, base + 2 * MT * 64, 64);
            } else if (u.pn == 5) {
                bf16_t* base = PROJ + PK_OFF + (size_t)k64 * MT * 64 + row * 64 + c64;
                tile<0>(acc, base, base + (PVV_OFF - PK_OFF), 64);
            } else {
                bf16_t* base = PROJ + PZ_OFF + (size_t)(4 * (u.pn - 7) + k64) * MT * 64 + row * 64 + c64;
                tile<3>(acc, base, base + 2 * MT * 64, 64);
            }
        } else {
            const int b = mem_b0 + (u.pm - mem_pm0); const size_t key = (size_t)wr * 64 + fr;
            bf16_t* base = MKV + (u.pn - 11) * MV_OFF + ((size_t)(b * 4 + k64) * MEM_LEN + key) * 64 + c64;
            tile<0>(acc, base, base + (size_t)2 * MEM_LEN * 64, 64);
        }
    }
};
struct EpiOut {
    static constexpr bool PERM = true;
    bf16_t* O; float* SSP; int pm_base;
    __device__ __forceinline__ void operator()(const pg8::f32x4 (&acc)[2][2][4][2], const pg8::Unit& u, int wr, int wc, int fr, int fq) const {
        const int row0 = (pm_base + u.pm) * 256 + wr * 64 + fr, col0 = u.pn * 256 + wc * 32 + 8 * fq;
#pragma unroll
        for (int ai = 0; ai < 2; ++ai)
#pragma unroll
            for (int m = 0; m < 4; ++m) { const int row = row0 + ai * 128 + m * 16; bf16_t* rowp = O + (size_t)row * D_MODEL + col0; float ss = 0.f;
#pragma unroll
                for (int bj = 0; bj < 2; ++bj) { const pg8::f32x4 v0 = acc[ai][bj][m][0], v1 = acc[ai][bj][m][1];
                    ss += (v0[0] * v0[0] + v0[1] * v0[1]) + (v0[2] * v0[2] + v0[3] * v0[3]) + (v1[0] * v1[0] + v1[1] * v1[1]) + (v1[2] * v1[2] + v1[3] * v1[3]);
                    pg8::u32x4 w; w.x = pg8::cvt_pk_bf16(v0[0], v0[1]); w.y = pg8::cvt_pk_bf16(v0[2], v0[3]); w.z = pg8::cvt_pk_bf16(v1[0], v1[1]); w.w = pg8::cvt_pk_bf16(v1[2], v1[3]);
                    *(pg8::u32x4*)(rowp + bj * 128) = w; }
                ss += __shfl_xor(ss, 16); ss += __shfl_xor(ss, 32);
                if (fq == 0) SSP[(size_t)row * 16 + u.pn * 4 + wc] = ss; }
    }
};

__device__ __forceinline__ int t5_bucket(int n) {
    if (n < 16) return n;
    int l = 16 + (int)(__logf((float)n * (1.f / 16.f)) * (16.f / 2.0794415416798357f));
    return l < 31 ? l : 31;
}

namespace mix {
typedef short bf16x8 __attribute__((ext_vector_type(8)));
typedef short s16x4 __attribute__((ext_vector_type(4)));
typedef float f32x16 __attribute__((ext_vector_type(16)));
typedef unsigned u32x4 __attribute__((ext_vector_type(4))); typedef unsigned u32x2 __attribute__((ext_vector_type(2)));
typedef float f32x2_t __attribute__((ext_vector_type(2))); typedef __bf16 bf16x2_t __attribute__((ext_vector_type(2)));
constexpr int L1_OFF = 33280, STG_OFF = 66560, STG_WAVE = 8192, BIAS_OFF = 132096  , WSF_OFF = 136192, BSP_OFF = 138752  , VGB_OFF = 140800  ;
constexpr int SWA_VSTR = 256 * 64 + 64;
constexpr int X_KH = 16384, X_VH = 16512, X_VSTR = 128 * 64 + 64;
constexpr int G_GRP = 16640, G_CSTR = 64 * 64 + 64;

__device__ __forceinline__ int crow(int r, int hi) { return (r & 3) + 8 * (r >> 2) + 4 * hi; }
__device__ __forceinline__ s16x4 vtr(const LAS unsigned char* p) { return __builtin_bit_cast(s16x4, __builtin_amdgcn_ds_read_tr16_b64_v4i16((LAS s16x4*)p)); }
__device__ __forceinline__ unsigned cvtpk(float lo, float hi) { f32x2_t v = {lo, hi}; bf16x2_t b = __builtin_convertvector(v, bf16x2_t); return __builtin_bit_cast(unsigned, b); }
__device__ __forceinline__ u32x4 mul8(u32x4 a, u32x4 b) { u32x4 r;
#pragma unroll
    for (int e = 0; e < 4; ++e) r[e] = cvtpk(bflo(a[e]) * bflo(b[e]), bfhi(a[e]) * bfhi(b[e]));
    return r; }
__device__ __forceinline__ u32x4 mul8x3(u32x4 a, u32x4 b, u32x4 c) { u32x4 r;
#pragma unroll
    for (int e = 0; e < 4; ++e) r[e] = cvtpk(bflo(a[e]) * bflo(b[e]) * bflo(c[e]), bfhi(a[e]) * bfhi(b[e]) * bfhi(c[e]));
    return r; }

__device__ __forceinline__ f32x16 qk_block(const LAS unsigned char* Kt, int key0, const bf16x8 (&qf)[4], int r32, int hi, f32x16 s) {
    const int key = key0 + r32, sw = (key >> 1) & 7; const LAS unsigned char* kr = Kt + key * 128;
#pragma unroll
    for (int d0 = 0; d0 < 4; ++d0) { const bf16x8 kf = *(const LAS bf16x8*)(kr + (((2 * d0 + hi) ^ sw) << 4)); s = __builtin_amdgcn_mfma_f32_32x32x16_bf16(kf, qf[d0], s, 0, 0, 0); }
    return s;
}
__device__ __forceinline__ void pv_block(f32x16 (&o)[2], const f32x16& p, const LAS unsigned char* Vt, int vstr, int key0, int lane) {
    const LAS unsigned char* vb = Vt + (key0 + 4 * (lane >> 5) + ((lane >> 2) & 3)) * 64 + ((lane >> 4) & 1) * 32 + (lane & 3) * 8;
#pragma unroll
    for (int s = 0; s < 2; ++s) {
        u32x4 pw; pw[0] = cvtpk(p[8 * s + 0], p[8 * s + 1]); pw[1] = cvtpk(p[8 * s + 2], p[8 * s + 3]); pw[2] = cvtpk(p[8 * s + 4], p[8 * s + 5]); pw[3] = cvtpk(p[8 * s + 6], p[8 * s + 7]);
        const bf16x8 pa = __builtin_bit_cast(bf16x8, pw);
#pragma unroll
        for (int dblk = 0; dblk < 2; ++dblk) {
            const s16x4 lo = vtr(vb + dblk * vstr + s * 1024), hi4 = vtr(vb + dblk * vstr + s * 1024 + 512);
            const bf16x8 vf = {lo[0], lo[1], lo[2], lo[3], hi4[0], hi4[1], hi4[2], hi4[3]};
            o[dblk] = __builtin_amdgcn_mfma_f32_32x32x16_bf16(vf, pa, o[dblk], 0, 0, 0);
        }
    }
}
struct TileSrc { const bf16_t* p; long s_hi; };
__device__ __forceinline__ void load_half(u32x4 (&r)[4], const TileSrc t, int tid) {
    const bf16_t* p = t.p + (long)tid * 8;
#pragma unroll
    for (int it = 0; it < 4; ++it) r[it] = *(const u32x4*)(p + (it >> 1) * t.s_hi + (it & 1) * 4096);
}
__device__ __forceinline__ void write_k(const u32x4 (&r)[4], LAS unsigned char* L, bool zero_lo, int tid) {
    const int ch = tid & 7, kl = tid >> 3; LAS unsigned char* d = L + kl * 128 + ((ch ^ ((kl >> 1) & 7)) << 4);
    const unsigned keep = zero_lo ? 0u : 0xffffffffu;
#pragma unroll
    for (int it = 0; it < 4; ++it) { u32x4 v = r[it]; if (it < 2) { v[0] &= keep; v[1] &= keep; v[2] &= keep; v[3] &= keep; } *(LAS u32x4*)(d + it * 8192) = v; }
}
__device__ __forceinline__ void write_v_swa(const u32x4 (&r)[4], LAS unsigned char* L, bool zero_lo, int tid) {
    const int ch = tid & 7, kl = tid >> 3; LAS unsigned char* d = L + (ch >> 2) * SWA_VSTR + kl * 64 + (ch & 3) * 16;
    const unsigned keep = zero_lo ? 0u : 0xffffffffu;
#pragma unroll
    for (int it = 0; it < 4; ++it) { u32x4 v = r[it]; if (it < 2) { v[0] &= keep; v[1] &= keep; v[2] &= keep; v[3] &= keep; } *(LAS u32x4*)(d + it * 4096) = v; }
}
__device__ __forceinline__ void write_v_x(const u32x4 (&r)[4], LAS unsigned char* L, int tid) {
    const int ch = tid & 7, kl = tid >> 3; LAS unsigned char* d = L + (ch >> 2) * X_VSTR + kl * 64 + (ch & 3) * 16;
#pragma unroll
    for (int it = 0; it < 4; ++it) *(LAS u32x4*)(d + (it >> 1) * X_VH + (it & 1) * 4096) = r[it];
}
template <int CTRL> __device__ __forceinline__ float dpp_f(float v) { return __builtin_bit_cast(float, __builtin_amdgcn_update_dpp(0, __builtin_bit_cast(int, v), CTRL, 0xf, 0xf, false)); }
__device__ __forceinline__ float row16_sum(float v) {
    v += dpp_f<0xB1>(v); v += dpp_f<0x4E>(v); v += dpp_f<0x141>(v); v += dpp_f<0x140>(v);
    return v;
}
__device__ __forceinline__ void write_g(const u32x4 (&r)[4], LAS unsigned char* L, const LAS float* vgb, int gp, int tid) {
    const int ch = tid & 15;
#pragma unroll
    for (int it = 0; it < 4; ++it) { const int gl = it >> 1, srow = (it & 1) * 32 + (tid >> 4), g = 2 * gp + gl;
        float v[8];
#pragma unroll
        for (int e = 0; e < 4; ++e) { v[2 * e] = bflo(r[it][e]); v[2 * e + 1] = bfhi(r[it][e]); }
        const float mu = row16_sum(((v[0] + v[1]) + (v[2] + v[3])) + ((v[4] + v[5]) + (v[6] + v[7]))) * (1.f / 128.f); float sq = 0.f;
#pragma unroll
        for (int e = 0; e < 8; ++e) { v[e] -= mu; sq += v[e] * v[e]; }
        const float rs = rsqrtf(row16_sum(sq) * (1.f / 128.f) + EPS);
        const LAS f32x4* gq = (const LAS f32x4*)(vgb + g * 128 + ch * 8); const LAS f32x4* bq = (const LAS f32x4*)(vgb + 512 + g * 128 + ch * 8);
        const f32x4 g0 = gq[0], g1 = gq[1], b0 = bq[0], b1 = bq[1];
        u32x4 w;
        w[0] = cvtpk(v[0] * rs * g0[0] + b0[0], v[1] * rs * g0[1] + b0[1]); w[1] = cvtpk(v[2] * rs * g0[2] + b0[2], v[3] * rs * g0[3] + b0[3]);
        w[2] = cvtpk(v[4] * rs * g1[0] + b1[0], v[5] * rs * g1[1] + b1[1]); w[3] = cvtpk(v[6] * rs * g1[2] + b1[2], v[7] * rs * g1[3] + b1[3]);
        *(LAS u32x4*)(L + gl * G_GRP + (ch >> 2) * G_CSTR + srow * 64 + (ch & 3) * 16) = w; }
}
__device__ __forceinline__ void attn_out(const f32x16 (&o)[2], float rinv, LAS unsigned char* stg, const u32x4 (&zv)[4], bf16_t* yrow0, int lane) {
    const int r32 = lane & 31, hi = lane >> 5;
    LAS unsigned char* wr = stg + r32 * 128 + hi * 8; const int sw = (r32 >> 1) & 7;
#pragma unroll
    for (int dblk = 0; dblk < 2; ++dblk)
#pragma unroll
        for (int rq = 0; rq < 4; ++rq) { u32x2 w; w[0] = cvtpk(o[dblk][4 * rq] * rinv, o[dblk][4 * rq + 1] * rinv); w[1] = cvtpk(o[dblk][4 * rq + 2] * rinv, o[dblk][4 * rq + 3] * rinv);
            *(LAS u32x2*)(wr + (((dblk * 4 + rq) ^ sw) << 4)) = w; }
    LDS_WAIT();
#pragma unroll
    for (int i = 0; i < 4; ++i) { const int row = i * 8 + (lane >> 3), ch = lane & 7;
        const u32x4 v = *(const LAS u32x4*)(stg + row * 128 + ((ch ^ ((row >> 1) & 7)) << 4));
        *(u32x4*)(yrow0 + (size_t)row * D_MODEL + ch * 8) = mul8(v, zv[i]); }
    LDS_WAIT();
}
__device__ __forceinline__ void load_z4(u32x4 (&zv)[4], const bf16_t* zrow0, int lane) {
#pragma unroll
    for (int i = 0; i < 4; ++i) zv[i] = __builtin_nontemporal_load((const u32x4*)(zrow0 + (size_t)(i * 8 + (lane >> 3)) * 64 + (lane & 7) * 8));
}
__device__ __forceinline__ void load_q4(bf16x8 (&q)[4], const bf16_t* qp) {
#pragma unroll
    for (int d0 = 0; d0 < 4; ++d0) q[d0] = *(const bf16x8*)(qp + 16 * d0);
}

__device__ __forceinline__ void mix_unit(int unit, LAS unsigned char* lds, const bf16_t* __restrict__ PROJ, const bf16_t* __restrict__ MKV, const bf16_t* __restrict__ WSP, bf16_t* __restrict__ Y, int tid, int wave) {
    const int b = unit >> 4, n = unit & 15, rb = wave & 3, wh = wave >> 2;
    const size_t row0 = (size_t)b * SEQ + (size_t)n * CHUNK;
    const size_t wrow0 = row0 + 32 * rb;
    LAS unsigned char* const L0 = lds; LAS unsigned char* const L1 = lds + L1_OFF;
    LAS unsigned char* stg = lds + STG_OFF + wave * STG_WAVE;
    const LAS float* btab = (const LAS float*)(lds + BIAS_OFF);
    const LAS float* bstab = (const LAS float*)(lds + BSP_OFF);
    const LAS float* vgb = (const LAS float*)(lds + VGB_OFF);
    const int tid_in = tid;
    const bool first = (n == 0);
#define MIX_BAR() asm volatile("s_waitcnt lgkmcnt(0)\n\ts_barrier" ::: "memory")
#define MIX_LANES() int tid = tid_in; asm volatile("" : "+v"(tid)); const int lane = tid & 63, r32 = lane & 31, hi = lane >> 5; const size_t qoff = (wrow0 + r32) * 64 + 8 * hi;
    auto tile_src = [&](int j) -> TileSrc {
        TileSrc t; j = j > 15 ? 15 : j;
        if (j < 4) { t.p = PROJ + ((j & 1) ? PVV_OFF : PK_OFF) + (size_t)(j >> 1) * MT * 64 + ((long)row0 - 128) * 64; t.s_hi = 8192; }
        else if (j < 12) { const int x = j - 4, st = x >> 1; t.p = MKV + ((x & 1) ? MV_OFF : 0) + ((size_t)(b * 4 + 2 * (st >> 1)) * MEM_LEN + (st & 1) * 128) * 64; t.s_hi = (long)MEM_LEN * 64; }
        else { const int y = j - 12; t.p = PROJ + PV_OFF + (size_t)(2 * (y >> 1)) * MT * 128 + (row0 + (y & 1) * 64) * 128; t.s_hi = (long)MT * 128; }
        return t; };
    u32x4 R0[4], R1[4]; bf16x8 qf[4];
    { MIX_LANES();
      load_half(R0, tile_src(0), tid); load_q4(qf, PROJ + PQ_OFF + (size_t)wh * MT * 64 + qoff);
      MIX_BAR();
      write_k(R0, L0, first, tid);
      load_half(R1, tile_src(1), tid); load_half(R0, tile_src(2), tid); }

#pragma unroll 1
    for (int kvh = 0; kvh < 2; ++kvh) {
        const int h = 2 * kvh + wh, j = 2 * kvh;
        f32x16 s[5]; float rinv; u32x4 zv[4];
        { MIX_LANES(); (void)qoff;
          MIX_BAR();
          write_v_swa(R1, L1, first, tid);
          load_z4(zv, PROJ + PZ_OFF + (size_t)(8 + h) * MT * 64 + wrow0 * 64, lane);
          load_half(R1, tile_src(j + 3), tid);
#pragma unroll
          for (int t = 0; t < 5; ++t) {
              const LAS float* tb = btab + ((first && rb + t < 4) ? 4 : h) * 192 + (31 - r32 + 4 * hi);
#pragma unroll
              for (int r = 0; r < 16; ++r) s[t][r] = tb[32 * t + (r & 3) + 8 * (r >> 2)];
          }
#pragma unroll
          for (int t = 0; t < 5; ++t) s[t] = qk_block(L0, 32 * (rb + t), qf, r32, hi, s[t]);
          const float sink2 = btab[5 * 192 + h]; float m = sink2;
#pragma unroll
          for (int t = 0; t < 5; ++t)
#pragma unroll
              for (int r = 0; r < 16; ++r) m = fmaxf(m, s[t][r]);
          m = fmaxf(m, __shfl_xor(m, 32));
          float l = 0.f;
#pragma unroll
          for (int t = 0; t < 5; ++t)
#pragma unroll
              for (int r = 0; r < 16; ++r) { const float p = __builtin_amdgcn_exp2f(s[t][r] - m); s[t][r] = p; l += p; }
          l += __shfl_xor(l, 32);
          rinv = __builtin_amdgcn_rcpf(l + __builtin_amdgcn_exp2f(sink2 - m)); }
        { MIX_LANES();
          MIX_BAR();
          write_k(R0, L0, kvh == 0 && first, tid);
          load_q4(qf, PROJ + (kvh == 0 ? PQ_OFF + (size_t)(2 + wh) * MT * 64 : PMQ_OFF + (size_t)wh * MT * 64) + qoff);
          load_half(R0, tile_src(j + 4), tid);
          f32x16 o[2] = {};
#pragma unroll
          for (int t = 0; t < 5; ++t) pv_block(o, s[t], L1, SWA_VSTR, 32 * (rb + t), lane);
          attn_out(o, rinv, stg, zv, Y + wrow0 * D_MODEL + 512 + h * 64, lane); }
    }
    {
        float m = -INFINITY, l = 0.f; f32x16 o[2] = {};
#pragma unroll 1
        for (int st = 0; st < 4; ++st) {
            const int hp = st >> 1, half = st & 1, h = 2 * hp + wh, j = 4 + 2 * st;
            f32x16 s[4]; float f; u32x4 zv[4];
            { MIX_LANES(); (void)qoff;
              if (half == 0) { m = -INFINITY; l = 0.f; o[0] = (f32x16){}; o[1] = (f32x16){}; }
              MIX_BAR();
              write_v_x(R1, L1, tid);
              load_z4(zv, PROJ + PZ_OFF + (size_t)(12 + h) * MT * 64 + wrow0 * 64, lane);
              load_half(R1, tile_src(j + 3), tid);
              const LAS unsigned char* Kt = L0 + wh * X_KH;
#pragma unroll
              for (int t = 0; t < 4; ++t) s[t] = qk_block(Kt, 32 * t, qf, r32, hi, (f32x16){});
              float mloc = -INFINITY;
#pragma unroll
              for (int t = 0; t < 4; ++t)
#pragma unroll
                  for (int r = 0; r < 16; ++r) mloc = fmaxf(mloc, s[t][r]);
              mloc = fmaxf(mloc, __shfl_xor(mloc, 32));
              const float mn = fmaxf(m, mloc); f = __builtin_amdgcn_exp2f(m - mn);
              float ls = 0.f;
#pragma unroll
              for (int t = 0; t < 4; ++t)
#pragma unroll
                  for (int r = 0; r < 16; ++r) { const float p = __builtin_amdgcn_exp2f(s[t][r] - mn); s[t][r] = p; ls += p; }
              ls += __shfl_xor(ls, 32);
              l = l * f + ls; m = mn; }
            { MIX_LANES();
              MIX_BAR();
              if (st < 3) write_k(R0, L0, false, tid); else write_g(R0, L0, vgb, 0, tid);
              load_q4(qf, PROJ + PMQ_OFF + (size_t)(2 * (st < 3 ? ((st + 1) >> 1) : hp) + wh) * MT * 64 + qoff);
              load_half(R0, tile_src(j + 4), tid);
              if (half == 1) { o[0] *= f; o[1] *= f; }
              const LAS unsigned char* Vt = L1 + wh * X_VH;
#pragma unroll
              for (int t = 0; t < 4; ++t) pv_block(o, s[t], Vt, X_VSTR, 32 * t, lane);
              if (half == 1) attn_out(o, __builtin_amdgcn_rcpf(l), stg, zv, Y + wrow0 * D_MODEL + 768 + h * 64, lane); }
        }
    }
#pragma unroll 1
    for (int gp = 0; gp < 2; ++gp) {
        const int g = 2 * gp + wh, nks = 2 * rb + 2, j = 12 + 2 * gp;
        f32x16 acc[4] = {}; u32x4 uv[8], zv[8]; bf16x8 af[8];
        { MIX_LANES(); (void)qoff;
          const bf16_t* wrow = WSP + ((size_t)(g * 128 + 32 * rb + r32)) * 128 + 8 * hi;
#pragma unroll
          for (int ks = 0; ks < 8; ++ks) af[ks] = *(const bf16x8*)(wrow + 16 * ks);
          MIX_BAR();
          write_g(R1, L1, vgb, gp, tid);
#pragma unroll
          for (int i = 0; i < 8; ++i) { const size_t row = wrow0 + i * 4 + (lane >> 4); const int ch = lane & 15;
              uv[i] = __builtin_nontemporal_load((const u32x4*)(PROJ + PU_OFF + (size_t)g * MT * 128 + row * 128 + ch * 8));
              zv[i] = __builtin_nontemporal_load((const u32x4*)(PROJ + PZ_OFF + (size_t)(2 * g + (ch >> 3)) * MT * 64 + row * 64 + (ch & 7) * 8)); }
          load_half(R1, tile_src(j + 3), tid);
          const LAS unsigned char* tb = L0 + wh * G_GRP + (8 * hi + ((lane >> 2) & 3)) * 64 + ((lane >> 4) & 1) * 32 + (lane & 3) * 8;
#pragma unroll
          for (int ks = 0; ks < 4; ++ks) if (ks < nks) {
#pragma unroll
              for (int cb = 0; cb < 4; ++cb) {
                  const s16x4 lo = vtr(tb + cb * G_CSTR + ks * 1024), hi4 = vtr(tb + cb * G_CSTR + ks * 1024 + 256);
                  const bf16x8 bfv = {lo[0], lo[1], lo[2], lo[3], hi4[0], hi4[1], hi4[2], hi4[3]};
                  acc[cb] = __builtin_amdgcn_mfma_f32_32x32x16_bf16(bfv, af[ks], acc[cb], 0, 0, 0);
              }
          } }
        { MIX_LANES(); (void)qoff;
          MIX_BAR();
          if (gp == 0) write_g(R0, L0, vgb, 1, tid);
          load_half(R0, tile_src(j + 4), tid);
          const LAS unsigned char* tb = L1 + wh * G_GRP + (8 * hi + ((lane >> 2) & 3)) * 64 + ((lane >> 4) & 1) * 32 + (lane & 3) * 8;
#pragma unroll
          for (int ks = 4; ks < 8; ++ks) if (ks < nks) {
#pragma unroll
              for (int cb = 0; cb < 4; ++cb) {
                  const s16x4 lo = vtr(tb + cb * G_CSTR + (ks - 4) * 1024), hi4 = vtr(tb + cb * G_CSTR + (ks - 4) * 1024 + 256);
                  const bf16x8 bfv = {lo[0], lo[1], lo[2], lo[3], hi4[0], hi4[1], hi4[2], hi4[3]};
                  acc[cb] = __builtin_amdgcn_mfma_f32_32x32x16_bf16(bfv, af[ks], acc[cb], 0, 0, 0);
              }
          }
          const float bs = bstab[g * 128 + 32 * rb + r32];
          LAS unsigned char* wr = stg + r32 * 256 + hi * 8; const int sw = r32 & 15;
#pragma unroll
          for (int cb = 0; cb < 4; ++cb)
#pragma unroll
              for (int rq = 0; rq < 4; ++rq) { u32x2 w; w[0] = cvtpk(acc[cb][4 * rq] + bs, acc[cb][4 * rq + 1] + bs); w[1] = cvtpk(acc[cb][4 * rq + 2] + bs, acc[cb][4 * rq + 3] + bs);
                  *(LAS u32x2*)(wr + (((cb * 4 + rq) ^ sw) << 4)) = w; }
          LDS_WAIT();
#pragma unroll
          for (int i = 0; i < 8; ++i) { const int row = i * 4 + (lane >> 4), ch = lane & 15;
              const u32x4 sv = *(const LAS u32x4*)(stg + row * 256 + ((ch ^ (row & 15)) << 4));
              *(u32x4*)(Y + (wrow0 + row) * D_MODEL + g * 128 + ch * 8) = mul8x3(sv, uv[i], zv[i]); }
          LDS_WAIT(); }
    }
    { MIX_BAR(); }
#undef MIX_LANES
#undef MIX_BAR
}
}

__global__ void __launch_bounds__(NWAVES * 64, 2) hymba_fwd(Args args) {
    extern __shared__ __attribute__((aligned(16))) unsigned char lds_raw[];
    LAS unsigned char* lds = (LAS unsigned char*)lds_raw;
    volatile LAS unsigned* MISC = (volatile LAS unsigned*)(lds + MISC_OFF);
    const int tid = threadIdx.x, lane = tid & 63, wave = __builtin_amdgcn_readfirstlane(tid >> 6);
    const int G = gridDim.x; const int bx = blockIdx.x; const int vcu = (G % 8 == 0) ? (bx % 8) * (G / 8) + bx / 8 : bx;
    unsigned char* ws = args.ws;
    unsigned* ctl = (unsigned*)(ws + WS_CTL);
    bf16_t* WIN_T = (bf16_t*)(ws + WS_WIN); bf16_t* WOUT_T = (bf16_t*)(ws + WS_WOUT); bf16_t* WSP = (bf16_t*)(ws + WS_WSP); float* SSP = (float*)(ws + WS_SSP);
    bf16_t* XN = (bf16_t*)(ws + WS_XN); bf16_t* PROJ = (bf16_t*)(ws + WS_PROJ); bf16_t* MKV = (bf16_t*)(ws + WS_MKV); bf16_t* Y = (bf16_t*)(ws + WS_Y); bf16_t* O = (bf16_t*)(ws + WS_O);
    for (int u = tid; u < (LDS_BYTES - LDSCTL_OFF) / 4; u += NWAVES * 64) ((LAS unsigned*)(lds + LDSCTL_OFF))[u] = 0u;
    __syncthreads();
    const int NG = (G == 256) ? 2 : 1, Gg = G / NG, grp = bx / Gg, cg = bx - grp * Gg;
    const int vcug = (Gg % 8 == 0) ? (cg % 8) * (Gg / 8) + cg / 8 : cg;
    const int MH = M_TOK / NG, MMH = M_MEM / NG, row_base = grp * MH, pm_base = row_base / 256;
    XcdBarrier barG = xcd_barrier_post(ctl + CW_BAR, MISC + 8, (unsigned)G);
    XcdBarrier barH = barG;
    if (NG == 2) barH = xcd_barrier_post(ctl + CW_BAR + (1 + grp) * XCD_BAR_WORDS, MISC + 10, (unsigned)Gg);
    const int gw = vcu * NWAVES + wave, NGW = G * NWAVES, gwg = vcug * NWAVES + wave, NGWg = Gg * NWAVES;

    {
        rms_rows_to_bf16<4>(args.x, args.g_pre, XN, gw, MH, NGW, lane);
        rms_rows_to_bf16<2>(args.mem, args.g_mem, XN + (size_t)M_TOK * D_MODEL, gw, M_MEM, NGW, lane);
        LAS float* scr = (LAS float*)(lds + wave * 16384);
        constexpr int I_IN = (D_MODEL / 64) * (IN_WIDTH / 32), I_MKV = (D_MODEL / 64) * (MKV_W / 32), I_OUT = (D_MODEL / 64) * (D_MODEL / 32);
        for (int it = NGW - 1 - gw; it < I_IN + I_MKV + I_OUT; it += NGW) {
            int r = it;
            if (r < I_IN) { p0_transpose_item(args.w_in, D_MODEL, IN_WIDTH, WIN_T, 0, scr, r, lane); continue; } r -= I_IN;
            if (r < I_MKV) { p0_transpose_item(args.w_mkv, D_MODEL, MKV_W, WIN_T, IN_WIDTH, scr, r, lane); continue; } r -= I_MKV;
            p0_transpose_item(args.w_out, D_MODEL, D_MODEL, WOUT_T, 0, scr, r, lane);
        }
        for (int e = bx * 512 + tid; e < 4 * 128 * 128; e += G * 512) { const int s = e & 127, t = (e >> 7) & 127; WSP[e] = (bf16_t)f2bf(s <= t ? args.wsp[e] : 0.f); }
        xcd_barrier(barG);
    }
    if (grp == 1) {
        rms_rows_to_bf16<4>(args.x + (size_t)row_base * D_MODEL, args.g_pre, XN + (size_t)row_base * D_MODEL, gwg, MH, NGWg, lane);
        xcd_barrier(barH);
    }
    {
        pg8::Gemm g{XN + (size_t)row_base * D_MODEL, WIN_T, MH, IN_WIDTH + MKV_W, D_MODEL};
        pg8::MergedOrder S; S.S.init(MH, IN_WIDTH, Gg, cg, NG == 2 ? 4 : 8); S.eM = MMH / 256; S.eN = MKV_W / 256; S.ePm0 = (M_TOK + grp * MMH - row_base) / 256;
        EpiProj E{PROJ, MKV, pm_base, S.ePm0, grp * (BATCH / NG)};
        pg8::gemm_phase<EpiProj, pg8::MergedOrder, true, true>(lds, g, S, E);
        xcd_barrier(barH);
    }
    {
        for (int idx = tid; idx < 5 * 192; idx += NWAVES * 64) { const int h = idx / 192, dist = 159 - (idx % 192);
            ((LAS float*)(lds + mix::BIAS_OFF))[idx] = (h < 4 && dist >= 0 && dist < 128) ? args.relb[t5_bucket(dist) * 4 + h] * LOG2E : -INFINITY; }
        if (tid < 4) ((LAS float*)(lds + mix::BIAS_OFF))[5 * 192 + tid] = args.sinks[tid] * LOG2E;
        ((LAS float*)(lds + mix::BSP_OFF))[tid] = args.bsp[tid];
        ((LAS float*)(lds + mix::VGB_OFF))[tid] = args.vg[tid]; ((LAS float*)(lds + mix::VGB_OFF))[512 + tid] = args.vb[tid];
        __syncthreads();
        const int nu = BATCH * (SEQ / CHUNK) / NG;
        for (int u = vcug; u < nu; u += Gg) mix::mix_unit(grp * nu + u, lds, PROJ, MKV, WSP, Y, tid, wave);
        xcd_barrier(barH);
    }
    {
        pg8::Gemm g{Y + (size_t)row_base * D_MODEL, WOUT_T, MH, D_MODEL, D_MODEL};
        pg8::StaticOrder S; S.init(MH, D_MODEL, Gg, cg, NG == 2 ? 4 : 8);
        EpiOut E{O, SSP, pm_base};
        pg8::gemm_phase<EpiOut, pg8::StaticOrder, true, true>(lds, g, S, E);
        xcd_barrier(barH);
    }
    {
        const GAS f32x4* gp = (const GAS f32x4*)args.g_post + lane;
        f32x4 gg[4];
#pragma unroll
        for (int j = 0; j < 4; ++j) gg[j] = gp[64 * j];
        constexpr int NB = 4;
        const int m_end = row_base + MH;
        for (int m0 = row_base + gwg; m0 < m_end; m0 += NB * NGWg) {
            v2u ov[NB][4]; f32x4 xv[NB][4]; float ssp[NB];
#pragma unroll
            for (int i = 0; i < NB; ++i) { const int m = (m0 + i * NGWg < m_end) ? m0 + i * NGWg : m0;
                const GAS v2u* orow = (const GAS v2u*)(O + (size_t)m * D_MODEL) + lane; const GAS f32x4* xr = (const GAS f32x4*)(args.x + (size_t)m * D_MODEL) + lane;
#pragma unroll
                for (int j = 0; j < 4; ++j) { ov[i][j] = __builtin_nontemporal_load(&orow[64 * j]); xv[i][j] = __builtin_nontemporal_load(&xr[64 * j]); }
                ssp[i] = SSP[(size_t)m * 16 + (lane & 15)]; }
#pragma unroll
            for (int i = 0; i < NB; ++i) { const int m = m0 + i * NGWg;
                const float r = rsqrtf(wave_sum(ssp[i]) * 0.25f * (1.f / D_MODEL) + EPS);
                if (m < m_end) {
                    GAS f32x4* outr = (GAS f32x4*)(args.out + (size_t)m * D_MODEL) + lane;
#pragma unroll
                    for (int j = 0; j < 4; ++j) { f32x4 o;
                        o.x = xv[i][j].x + bflo(ov[i][j].x) * r * gg[j].x; o.y = xv[i][j].y + bfhi(ov[i][j].x) * r * gg[j].y; o.z = xv[i][j].z + bflo(ov[i][j].y) * r * gg[j].z; o.w = xv[i][j].w + bfhi(ov[i][j].y) * r * gg[j].w;
                        __builtin_nontemporal_store(o, &outr[64 * j]); }
                }
            }
        }
    }
}

extern "C" void kernel_launch(void* const* d_in, const int* in_sizes, int n_in, void* d_out, int out_size, void* d_ws, size_t ws_size, hipStream_t stream) {
    static int grid = 0;
    if (grid == 0) {
        if (n_in != 14 || in_sizes[0] != M_TOK * D_MODEL || out_size != M_TOK * D_MODEL || ws_size < WS_END) { fprintf(stderr, "kernel_launch: unexpected shapes (n_in %d, ws %zu)\n", n_in, ws_size); grid = -1; return; }
        int dev = 0, cus = 0, per_cu = 0;
        if (hipGetDevice(&dev) != hipSuccess || hipDeviceGetAttribute(&cus, hipDeviceAttributeMultiprocessorCount, dev) != hipSuccess) { grid = -1; return; }
        if (hipFuncSetAttribute((const void*)hymba_fwd, hipFuncAttributeMaxDynamicSharedMemorySize, LDS_BYTES) != hipSuccess) { fprintf(stderr, "kernel_launch: hipFuncSetAttribute failed\n"); grid = -1; return; }
        if (hipOccupancyMaxActiveBlocksPerMultiprocessor(&per_cu, (const void*)hymba_fwd, NWAVES * 64, LDS_BYTES) != hipSuccess || per_cu < 1) { fprintf(stderr, "kernel_launch: occupancy query says %d blocks/CU\n", per_cu); per_cu = 1; }
        (void)hipGetLastError();
        grid = cus;
    }
    if (grid < 0) return;
    (void)hipMemsetAsync((char*)d_ws + WS_CTL, 0, CTL_ZERO_BYTES, stream);
    Args a{};
    a.x = (const float*)d_in[0]; a.mem = (const float*)d_in[1]; a.g_pre = (const float*)d_in[2]; a.g_post = (const float*)d_in[3]; a.g_mem = (const float*)d_in[4];
    a.w_in = (const float*)d_in[5]; a.w_mkv = (const float*)d_in[6]; a.vg = (const float*)d_in[7]; a.vb = (const float*)d_in[8]; a.wsp = (const float*)d_in[9]; a.bsp = (const float*)d_in[10];
    a.sinks = (const float*)d_in[11]; a.relb = (const float*)d_in[12]; a.w_out = (const float*)d_in[13];
    a.out = (float*)d_out; a.ws = (unsigned char*)d_ws;
    hipLaunchKernelGGL(hymba_fwd, dim3(grid), dim3(NWAVES * 64), LDS_BYTES, stream, a);
}
```

```cpp
#include <hip/hip_runtime.h>
#include <cstdio>
#include <cstdint>

namespace pg8 {
#define PG8_LAS __attribute__((address_space(3)))
typedef unsigned short bf16_t;
typedef short bf16x8 __attribute__((ext_vector_type(8)));
typedef float f32x4 __attribute__((ext_vector_type(4)));
typedef unsigned u32x4 __attribute__((ext_vector_type(4)));
constexpr int BM = 256, BK = 64, HALF = 128, HTB = HALF * BK * 2, STAGE_BYTES = 8 * HTB, NXCD = 8, WGM = 8;

__host__ __device__ __forceinline__ int lds_byte(int r, int c) { const int st = (r >> 4) * 2 + (c >> 5), rr = r & 15, cc = c & 31, ob = rr * 64 + cc * 2; return st * 1024 + (ob ^ (((ob >> 9) & 1) << 5)); }
__host__ __device__ __forceinline__ void stage_rc(int b, int& R, int& C) { const int st = b / 1024, sb = b % 1024, swz = sb ^ (((sb >> 9) & 1) << 5); R = (st >> 1) * 16 + swz / 64; C = (st & 1) * 32 + (swz % 64) / 2; }
__host__ __device__ __forceinline__ int perm32(int rho) { const int n = rho >> 4, i = rho & 15; return 8 * (i >> 2) + 4 * n + (i & 3); }

struct Unit { int pm, pn; };
struct Gemm { const bf16_t* A; const bf16_t* Bt; int M, N, K; };

struct StaticOrder {
    int nM, nN, nwg, G, c, wgm;
    __host__ __device__ void init(int M, int N, int G_, int c_, int wgm_ = WGM) { nM = M / BM; nN = N / BM; nwg = nM * nN; G = G_; c = c_; wgm = wgm_; }
    __host__ __device__ void map(int wgid, Unit& u) const {
        { const int q = nwg / NXCD, r = nwg % NXCD, xcd = wgid % NXCD, off = wgid / NXCD; wgid = (xcd < r ? xcd * (q + 1) : r * (q + 1) + (xcd - r) * q) + off; }
        const int nig = wgm * nN, gid = wgid / nig, fm = gid * wgm, gsz = (nM - fm) < wgm ? (nM - fm) : wgm;
        u.pm = fm + ((wgid % nig) % gsz); u.pn = (wgid % nig) / gsz;
    }
    __host__ __device__ bool next(int i, Unit& u) const { const long L = (long)i * G + c; if (L >= nwg) return false; map((int)L, u); return true; }
    __device__ __forceinline__ void a_ready(const Unit&) const {}
    __device__ __forceinline__ void done(const Unit&) const {}
};
struct MergedOrder {
    StaticOrder S; int eM, eN, ePm0;
    __host__ __device__ bool next(int i, Unit& u) const {
        const int G = S.G, c = S.c, nfull = S.nwg / G, rem = S.nwg - nfull * G, nx = eM * eN;
        if (nfull < 1 || rem + 2 * nx > G) {
            if (S.next(i, u)) return true;
            const long L = (long)i * G + c - S.nwg; if (L >= (long)nx) return false;
            u.pm = ePm0 + (int)(L / eN); u.pn = S.nN + (int)(L % eN); return true;
        }
        if (c >= rem && c < rem + nx) {
            if (i < nfull - 1) return S.next(i, u);
            if (i > nfull - 1) return false;
            const int e = c - rem; u.pm = ePm0 + e / eN; u.pn = S.nN + e % eN; return true;
        }
        if (c >= rem + nx && c < rem + 2 * nx) {
            if (i < nfull) return S.next(i, u);
            if (i > nfull) return false;
            S.map((nfull - 1) * G + (c - nx), u); return true;
        }
        return S.next(i, u);
    }
    __device__ __forceinline__ void a_ready(const Unit&) const {}
    __device__ __forceinline__ void done(const Unit&) const {}
};

__device__ __forceinline__ unsigned cvt_pk_bf16(float lo, float hi) { unsigned r; asm volatile("v_cvt_pk_bf16_f32 %0, %1, %2" : "=v"(r) : "v"(lo), "v"(hi)); return r; }
__device__ __forceinline__ unsigned cvt_pk_f16(float lo, float hi) { unsigned r; asm volatile("v_cvt_pk_f16_f32 %0, %1, %2" : "=v"(r) : "v"(lo), "v"(hi)); return r; }
template <bool F16> __device__ __forceinline__ f32x4 mma16(bf16x8 a, bf16x8 b, f32x4 c) {
    if constexpr (F16) { typedef _Float16 h16x8 __attribute__((ext_vector_type(8))); return __builtin_amdgcn_mfma_f32_16x16x32_f16(__builtin_bit_cast(h16x8, a), __builtin_bit_cast(h16x8, b), c, 0, 0, 0); }
    else return __builtin_amdgcn_mfma_f32_16x16x32_bf16(a, b, c, 0, 0, 0);
}

template <class Epi, class Sched, bool ALIGN_EPI = false, bool SP2 = false>
__device__ __forceinline__ void gemm_phase(PG8_LAS unsigned char* lds, const Gemm g, const Sched& S, const Epi& E) {
    const int tid = threadIdx.x, wid = __builtin_amdgcn_readfirstlane(tid >> 6), lane = tid & 63, wr = wid >> 2, wc = wid & 3, fr = lane & 15, fq = lane >> 4;
    const int K = g.K, nt = K / BK;
    unsigned voffA[2], voffB[2];
#pragma unroll
    for (int i = 0; i < 2; ++i) { int R, C; stage_rc(tid * 16 + i * 8192, R, C); const int Rb = Epi::PERM ? ((R & ~31) + perm32(R & 31)) : R;
        voffA[i] = (unsigned)(R * K + C) * 2u; voffB[i] = (unsigned)(Rb * K + C) * 2u; }
    const size_t kstep = (size_t)(BK * 2);
    const size_t hstep = (size_t)HALF * K * 2;
    const size_t tstep = 2 * hstep;
    const unsigned ldsw = (unsigned)wid * 1024u;
    const int aoff = lds_byte(wr * 64 + fr, fq * 8), boff = lds_byte(wc * 32 + fr, fq * 8);
#define PG8_SA(b, h) (((b) * 2 + (h)) * HTB)
#define PG8_SB(b, h) ((4 + (b) * 2 + (h)) * HTB)
#define PG8_STAGE(bufoff, gbase, voff) do { _Pragma("unroll") for (int _i = 0; _i < 2; ++_i) \
        __builtin_amdgcn_global_load_lds((const unsigned*)((const char*)(gbase) + (voff)[_i]), (PG8_LAS unsigned*)(lds + (bufoff) + ldsw + _i * 8192), 16, 0, 0); } while (0)
#define PG8_LDA(dst, b, h) do { _Pragma("unroll") for (int m = 0; m < 4; ++m) _Pragma("unroll") for (int k = 0; k < 2; ++k) dst[m][k] = *(const PG8_LAS bf16x8*)(lds + PG8_SA(b, h) + aoff + m * 2048 + k * 1024); } while (0)
#define PG8_LDB(dst, b, h) do { _Pragma("unroll") for (int n = 0; n < 2; ++n) _Pragma("unroll") for (int k = 0; k < 2; ++k) dst[n][k] = *(const PG8_LAS bf16x8*)(lds + PG8_SB(b, h) + boff + n * 2048 + k * 1024); } while (0)
#define PG8_MMA(ai, bj, At, Bt) do { __builtin_amdgcn_s_setprio(1); _Pragma("unroll") for (int m = 0; m < 4; ++m) _Pragma("unroll") for (int n = 0; n < 2; ++n) _Pragma("unroll") for (int k = 0; k < 2; ++k) \
        acc[ai][bj][m][n] = mma16<Epi::F16>(Bt[n][k], At[m][k], acc[ai][bj][m][n]); __builtin_amdgcn_s_setprio(0); } while (0)
#define PG8_WAIT_V(n) asm volatile("s_waitcnt vmcnt(" #n ")" ::: "memory")
#define PG8_WAIT_L(n) asm volatile("s_waitcnt lgkmcnt(" #n ")" ::: "memory")
#define PG8_BAR __builtin_amdgcn_s_barrier()
#define PG8_SCHED __builtin_amdgcn_sched_barrier(0)
    Unit cur, nxt; int ui = 0;
    if (!S.next(0, cur)) return;
    f32x4 acc[2][2][4][2];
#pragma unroll
    for (int a = 0; a < 2; ++a)
#pragma unroll
        for (int b = 0; b < 2; ++b)
#pragma unroll
            for (int m = 0; m < 4; ++m)
#pragma unroll
                for (int n = 0; n < 2; ++n) acc[a][b][m][n] = (f32x4){0.f, 0.f, 0.f, 0.f};
    bf16x8 At[4][2], B0[2][2], B1[2][2];
    const char* cA = (const char*)g.A + (size_t)cur.pm * tstep; const char* cB = (const char*)g.Bt + (size_t)cur.pn * tstep;
    S.a_ready(cur);
    if constexpr (SP2) {
        PG8_STAGE(PG8_SB(0, 0), cB, voffB); PG8_STAGE(PG8_SB(0, 1), cB + hstep, voffB); PG8_STAGE(PG8_SA(0, 0), cA, voffA); PG8_STAGE(PG8_SA(0, 1), cA + hstep, voffA);
        if (wr == 1) PG8_BAR;
        PG8_WAIT_V(2); PG8_BAR;
        PG8_STAGE(PG8_SB(1, 0), cB + kstep, voffB); PG8_STAGE(PG8_SA(1, 0), cA + kstep, voffA); PG8_STAGE(PG8_SB(1, 1), cB + hstep + kstep, voffB);
        PG8_WAIT_V(6); PG8_BAR;
    } else {
        PG8_STAGE(PG8_SB(0, 0), cB, voffB); PG8_STAGE(PG8_SA(0, 0), cA, voffA); PG8_STAGE(PG8_SB(0, 1), cB + hstep, voffB); PG8_STAGE(PG8_SA(0, 1), cA + hstep, voffA);
        if (wr == 1) PG8_BAR;
        PG8_WAIT_V(4); PG8_BAR;
        PG8_STAGE(PG8_SB(1, 0), cB + kstep, voffB); PG8_STAGE(PG8_SA(1, 0), cA + kstep, voffA); PG8_STAGE(PG8_SB(1, 1), cB + hstep + kstep, voffB);
        PG8_WAIT_V(6); PG8_BAR;
    }
    for (;;) {
        const bool has_next = S.next(ui + 1, nxt);
        const char* nA = has_next ? (const char*)g.A + (size_t)nxt.pm * tstep : cA; const char* nB = has_next ? (const char*)g.Bt + (size_t)nxt.pn * tstep : cB;
        for (int t = 0; t < nt; t += 2) {
            const bool last = (t == nt - 2);
            const char* a1 = cA + (size_t)(t + 1) * kstep;
            const char* a2 = last ? nA : cA + (size_t)(t + 2) * kstep; const char* b2 = last ? nB : cB + (size_t)(t + 2) * kstep;
            const char* a3 = a2 + kstep; const char* b3 = b2 + kstep;
            if (last && has_next) S.a_ready(nxt);
            if constexpr (SP2) {
            PG8_LDB(B0, 0, 0); PG8_LDB(B1, 0, 1); PG8_SCHED; PG8_LDA(At, 0, 0); PG8_STAGE(PG8_SA(1, 1), a1 + hstep, voffA);
            PG8_WAIT_V(8); PG8_WAIT_L(0); PG8_BAR; PG8_MMA(0, 0, At, B0); PG8_MMA(0, 1, At, B1); PG8_BAR; PG8_SCHED;
            PG8_LDA(At, 0, 1); PG8_STAGE(PG8_SB(0, 0), b2, voffB); PG8_STAGE(PG8_SB(0, 1), b2 + hstep, voffB); PG8_STAGE(PG8_SA(0, 0), a2, voffA);
            PG8_WAIT_V(8); PG8_WAIT_L(0); PG8_BAR; PG8_MMA(1, 0, At, B0); PG8_MMA(1, 1, At, B1); PG8_BAR; PG8_SCHED;
            PG8_LDB(B0, 1, 0); PG8_LDB(B1, 1, 1); PG8_SCHED; PG8_LDA(At, 1, 0); PG8_STAGE(PG8_SA(0, 1), a2 + hstep, voffA);
            PG8_WAIT_V(8); PG8_WAIT_L(0); PG8_BAR; PG8_MMA(0, 0, At, B0); PG8_MMA(0, 1, At, B1); PG8_BAR; PG8_SCHED;
            PG8_LDA(At, 1, 1); PG8_STAGE(PG8_SB(1, 0), b3, voffB); PG8_STAGE(PG8_SB(1, 1), b3 + hstep, voffB); PG8_STAGE(PG8_SA(1, 0), a3, voffA);
            PG8_WAIT_V(8); PG8_WAIT_L(0); PG8_BAR; PG8_MMA(1, 0, At, B0); PG8_MMA(1, 1, At, B1); PG8_BAR; PG8_SCHED;
            } else {
            PG8_LDB(B0, 0, 0); PG8_SCHED; PG8_LDA(At, 0, 0); PG8_STAGE(PG8_SA(1, 1), a1 + hstep, voffA);
            PG8_WAIT_L(8); PG8_BAR; PG8_WAIT_L(0); PG8_MMA(0, 0, At, B0); PG8_BAR; PG8_SCHED;
            PG8_LDB(B1, 0, 1); PG8_STAGE(PG8_SB(0, 0), b2, voffB);
            PG8_BAR; PG8_WAIT_L(0); PG8_MMA(0, 1, At, B1); PG8_BAR;
            PG8_LDA(At, 0, 1); PG8_STAGE(PG8_SA(0, 0), a2, voffA);
            PG8_BAR; PG8_WAIT_L(0); PG8_MMA(1, 0, At, B0); PG8_BAR; PG8_SCHED;
            PG8_STAGE(PG8_SB(0, 1), b2 + hstep, voffB);
            PG8_WAIT_V(6); PG8_BAR; PG8_MMA(1, 1, At, B1); PG8_BAR;
            PG8_LDB(B0, 1, 0); PG8_SCHED; PG8_LDA(At, 1, 0); PG8_STAGE(PG8_SA(0, 1), a2 + hstep, voffA);
            PG8_WAIT_L(8); PG8_BAR; PG8_WAIT_L(0); PG8_MMA(0, 0, At, B0); PG8_BAR; PG8_SCHED;
            PG8_LDB(B1, 1, 1); PG8_STAGE(PG8_SB(1, 0), b3, voffB);
            PG8_BAR; PG8_WAIT_L(0); PG8_MMA(0, 1, At, B1); PG8_BAR;
            PG8_LDA(At, 1, 1); PG8_STAGE(PG8_SA(1, 0), a3, voffA);
            PG8_BAR; PG8_WAIT_L(0); PG8_MMA(1, 0, At, B0); PG8_BAR; PG8_SCHED;
            PG8_STAGE(PG8_SB(1, 1), b3 + hstep, voffB);
            PG8_WAIT_V(6); PG8_BAR; PG8_MMA(1, 1, At, B1); PG8_BAR;
            }
        }
        if constexpr (ALIGN_EPI) { if (wr == 0) PG8_BAR; }
        E(acc, cur, wr, wc, fr, fq); S.done(cur);
        if (!has_next) break;
#pragma unroll
        for (int a = 0; a < 2; ++a)
#pragma unroll
            for (int b = 0; b < 2; ++b)
#pragma unroll
                for (int m = 0; m < 4; ++m)
#pragma unroll
                    for (int n = 0; n < 2; ++n) acc[a][b][m][n] = (f32x4){0.f, 0.f, 0.f, 0.f};
        cur = nxt; cA = nA; cB = nB; ++ui;
        if constexpr (ALIGN_EPI) { if (wr == 1) PG8_BAR; }
    }
    PG8_WAIT_V(0);
    if constexpr (!ALIGN_EPI) { if (wr == 0) PG8_BAR; }
    PG8_BAR;
#undef PG8_SA
#undef PG8_SB
#undef PG8_STAGE
#undef PG8_LDA
#undef PG8_LDB
#undef PG8_MMA
#undef PG8_WAIT_V
#undef PG8_WAIT_L
#undef PG8_BAR
#undef PG8_SCHED
}
}

typedef unsigned short bf16_t;
constexpr int D_MODEL = 1024, BATCH = 16, SEQ = 2048, MEM_LEN = 256, HD = 64, CHUNK = 128;
constexpr int M_TOK = BATCH * SEQ, M_MEM = BATCH * MEM_LEN;
constexpr int A_WIDTH = 512, IN_WIDTH = 2816, MKV_W = 512;
constexpr int C_U = 0, C_V = 512, C_SQ = 1024, C_SK = 1280, C_SV = 1408, C_MQ = 1536, C_Z = 1792;
constexpr size_t MT = (size_t)BATCH * SEQ;
constexpr size_t PU_OFF = 0, PV_OFF = PU_OFF + 4 * MT * 128, PQ_OFF = PV_OFF + 4 * MT * 128, PK_OFF = PQ_OFF + 4 * MT * 64, PVV_OFF = PK_OFF + 2 * MT * 64, PMQ_OFF = PVV_OFF + 2 * MT * 64, PZ_OFF = PMQ_OFF + 4 * MT * 64;
static_assert(PZ_OFF + 16 * MT * 64 == MT * 2816, "blocked PROJ layout covers exactly IN_WIDTH columns");
constexpr size_t MV_OFF = (size_t)BATCH * 4 * MEM_LEN * 64;
constexpr float EPS = 1e-6f;
constexpr float LOG2E = 1.4426950408889634f;
constexpr float QSCALE = 0.125f * LOG2E;
constexpr int NWAVES = 8;

constexpr size_t MiB = 1u << 20;
constexpr size_t WS_CTL = 0, CTL_ZERO_BYTES = 64 * 1024;
constexpr size_t WS_WIN = 2 * MiB;
constexpr size_t WS_WOUT = 10 * MiB;
constexpr size_t WS_WSP = 12 * MiB;
constexpr size_t WS_SSP = 13 * MiB;
constexpr size_t WS_XN = 16 * MiB;
constexpr size_t WS_PROJ = 96 * MiB;
constexpr size_t WS_MKV = 272 * MiB;
constexpr size_t WS_Y = 280 * MiB;
constexpr size_t WS_O = 344 * MiB;
constexpr size_t WS_END = 408 * MiB;
constexpr int CW_BAR = 1024;

constexpr int RING_BYTES = 131072, LDSCTL_OFF = 138240, MISC_OFF = LDSCTL_OFF + 320, LDS_BYTES = 147456;

#define GAS __attribute__((address_space(1)))
#define LAS __attribute__((address_space(3)))
typedef unsigned v4u __attribute__((ext_vector_type(4)));
typedef unsigned v2u __attribute__((ext_vector_type(2)));
typedef float f32x4 __attribute__((ext_vector_type(4)));
#define LDS_WAIT() asm volatile("s_waitcnt lgkmcnt(0)" ::: "memory")
#define VM_WAIT() asm volatile("s_waitcnt vmcnt(0)" ::: "memory")
__device__ __forceinline__ float bf2f(bf16_t v) { return __builtin_bit_cast(float, (unsigned)v << 16); }
__device__ __forceinline__ unsigned f2bf(float f) { unsigned u = __builtin_bit_cast(unsigned, f); return (u + 0x7fffu + ((u >> 16) & 1u)) >> 16; }
__device__ __forceinline__ unsigned pk2(float lo, float hi) { return f2bf(lo) | (f2bf(hi) << 16); }
__device__ __forceinline__ float bflo(unsigned w) { return __builtin_bit_cast(float, w << 16); }
__device__ __forceinline__ float bfhi(unsigned w) { return __builtin_bit_cast(float, w & 0xffff0000u); }
__device__ __forceinline__ float fast_sigmoid_mul(float x, float t) { return x * __builtin_amdgcn_rcpf(1.f + __builtin_amdgcn_exp2f(-t * LOG2E)); }
__device__ __forceinline__ float gelu_tanh(float x) { return fast_sigmoid_mul(x, 1.5957691216057308f * (x + 0.044715f * x * x * x)); }
__device__ __forceinline__ float silu(float x) { return fast_sigmoid_mul(x, x); }
typedef float f32x2 __attribute__((ext_vector_type(2)));
__device__ __forceinline__ f32x2 sigmoid_mul_pk(f32x2 x, f32x2 tneg) {
    f32x2 e; e.x = __builtin_amdgcn_exp2f(tneg.x); e.y = __builtin_amdgcn_exp2f(tneg.y);
    const f32x2 d = e + 1.0f; f32x2 r; r.x = __builtin_amdgcn_rcpf(d.x); r.y = __builtin_amdgcn_rcpf(d.y);
    return x * r;
}
__device__ __forceinline__ f32x2 gelu_tanh_pk(f32x2 x) { const f32x2 x2 = x * x; const f32x2 q = x2 * (-0.044715f * 1.5957691216057308f * LOG2E) + (-1.5957691216057308f * LOG2E); return sigmoid_mul_pk(x, x * q); }
__device__ __forceinline__ f32x2 silu_pk(f32x2 x) { return sigmoid_mul_pk(x, x * (-LOG2E)); }
__device__ __forceinline__ float wave_sum(float v) {
#pragma unroll
    for (int o = 1; o < 64; o <<= 1) v += __shfl_xor(v, o);
    return v;
}

#define XB_TMO      128
#define XB_XCNT(j)  (256  + 64 * (j))
#define XB_XSUB(j)  (1280 + 64 * (j))
#define XB_XGEN(j)  (2304 + 64 * (j))
#define XB_TOP      3328
#define XB_TOPGEN   3392
#define XCD_BAR_WORDS 3456
#define XB_SPIN_CAP (1u << 18)
__device__ __forceinline__ unsigned xb_ld(unsigned* p)              { return __hip_atomic_load(p, __ATOMIC_RELAXED, __HIP_MEMORY_SCOPE_AGENT); }
__device__ __forceinline__ unsigned xb_add(unsigned* p, unsigned v) { return __hip_atomic_fetch_add(p, v, __ATOMIC_RELAXED, __HIP_MEMORY_SCOPE_AGENT); }
__device__ __forceinline__ unsigned xb_xcc_id() { return (unsigned)__builtin_amdgcn_s_getreg((3 << 11) | 20) & 0xFu; }
#define XB_SPIN(cond, bar) do { unsigned _sp = 0; while (cond) { __builtin_amdgcn_s_sleep(1); \
    if ((++_sp & 255u) == 0u) { if (xb_ld(&(bar)[XB_TMO])) break; if (_sp > XB_SPIN_CAP) { atomicAdd(&(bar)[XB_TMO], 1u); break; } } } } while (0)
struct XcdBarrier { unsigned* bar; unsigned x; volatile LAS unsigned* st; unsigned n; };
__device__ __forceinline__ XcdBarrier xcd_barrier_post(unsigned* bar, volatile LAS unsigned* st, unsigned n) {
    XcdBarrier b; b.bar = bar; b.x = xb_xcc_id(); b.st = st; b.n = n;
    if (threadIdx.x == 0) (void)xb_add(&bar[XB_XCNT(b.x)], 1u);
    return b;
}
__device__ __forceinline__ void xcd_barrier_complete(unsigned* bar, unsigned x, unsigned G, unsigned& nloc, unsigned& nx) {
    unsigned sum, cnt, mine, sp = 0u;
    for (;;) {
        sum = 0u; cnt = 0u; mine = 0u;
#pragma unroll
        for (unsigned j = 0; j < 16; ++j) { const unsigned c = xb_ld(&bar[XB_XCNT(j)]); sum += c; cnt += (c > 0u) ? 1u : 0u; mine = (j == x) ? c : mine; }
        if (sum == G) break;
        __builtin_amdgcn_s_sleep(1);
        if ((++sp & 255u) == 0u) { if (xb_ld(&bar[XB_TMO])) break; if (sp > XB_SPIN_CAP) { atomicAdd(&bar[XB_TMO], 1u); break; } }
    }
    nloc = mine > 0u ? mine : 1u; nx = cnt > 0u ? cnt : 1u;
}
__device__ __forceinline__ void xcd_barrier(const XcdBarrier& b) {
    asm volatile("s_waitcnt vmcnt(0)" ::: "memory");
    __syncthreads();
    if (threadIdx.x == 0) {
        unsigned* bar = b.bar;
        __builtin_amdgcn_s_waitcnt(0);
        unsigned nloc = b.st[0], nx = b.st[1];
        if (nloc == 0u) { xcd_barrier_complete(bar, b.x, b.n, nloc, nx); b.st[0] = nloc; b.st[1] = nx; }
        const unsigned old = xb_add(&bar[XB_XSUB(b.x)], 1u);
        const unsigned gen = old / nloc;
        if (old + 1u == (gen + 1u) * nloc) {
            __builtin_amdgcn_fence(__ATOMIC_RELEASE, "agent");
            asm volatile("s_waitcnt vmcnt(0)" ::: "memory");
            const unsigned og = xb_add(&bar[XB_TOP], 1u);
            const unsigned tg = og / nx;
            if (og + 1u == (tg + 1u) * nx) xb_add(&bar[XB_TOPGEN], 1u);
            else XB_SPIN(xb_ld(&bar[XB_TOPGEN]) == tg, bar);
            __builtin_amdgcn_fence(__ATOMIC_ACQUIRE, "agent");
            xb_add(&bar[XB_XGEN(b.x)], 1u);
            asm volatile("s_waitcnt vmcnt(0)" ::: "memory");
        } else {
            XB_SPIN(xb_ld(&bar[XB_XGEN(b.x)]) == gen, bar);
            __builtin_amdgcn_fence(__ATOMIC_ACQUIRE, "agent");
            asm volatile("s_waitcnt vmcnt(0)" ::: "memory");
        }
    }
    __syncthreads();
}

struct Args {
    const float *x, *mem, *g_pre, *g_post, *g_mem, *w_in, *w_mkv, *vg, *vb, *wsp, *bsp, *sinks, *relb, *w_out;
    float* out; unsigned char* ws;
};

template <bool H> __device__ __forceinline__ void p0_transpose_item(const float* W, int K, int N, bf16_t* WT, int row_off, LAS float* scr, int item, int lane) {
    const int nblk = N / 32, kb = item / nblk, nb = item % nblk, k0 = 64 * kb, n0 = 32 * nb;
    float wv[32];
#pragma unroll
    for (int i = 0; i < 32; ++i) wv[i] = W[(size_t)(k0 + 2 * i + (lane >> 5)) * N + n0 + (lane & 31)];
#pragma unroll
    for (int i = 0; i < 32; ++i) scr[(2 * i + (lane >> 5)) * 33 + (lane & 31)] = wv[i];
    LDS_WAIT(); asm volatile("" ::: "memory");
    const int c = lane & 7;
#pragma unroll
    for (int j = 0; j < 4; ++j) { const int n = (lane >> 3) + 8 * j; const LAS float* s = scr + (8 * c) * 33 + n;
        v4u o;
        if constexpr (H) { o.x = pg8::cvt_pk_f16(s[0 * 33], s[1 * 33]); o.y = pg8::cvt_pk_f16(s[2 * 33], s[3 * 33]); o.z = pg8::cvt_pk_f16(s[4 * 33], s[5 * 33]); o.w = pg8::cvt_pk_f16(s[6 * 33], s[7 * 33]); }
        else { o.x = pk2(s[0 * 33], s[1 * 33]); o.y = pk2(s[2 * 33], s[3 * 33]); o.z = pk2(s[4 * 33], s[5 * 33]); o.w = pk2(s[6 * 33], s[7 * 33]); }
        *(GAS v4u*)(WT + (size_t)(row_off + n0 + n) * K + k0 + 8 * c) = o; }
    LDS_WAIT(); asm volatile("" ::: "memory");
}
template <int NB> __device__ __forceinline__ void rms_rows_to_bf16(const float* src, const float* g, bf16_t* dst, int m0, int m1, int step, int lane) {
    if (m0 >= m1) return;
    const int mlast = m0 + ((m1 - 1 - m0) / step) * step;
    const GAS f32x4* gr = (const GAS f32x4*)g + lane;
    f32x4 gg[4];
#pragma unroll
    for (int j = 0; j < 4; ++j) gg[j] = gr[64 * j];
    f32x4 v[NB][4], nx[NB][4];
#pragma unroll
    for (int i = 0; i < NB; ++i) { const int mr = m0 + i * step < mlast ? m0 + i * step : mlast; const GAS f32x4* xr = (const GAS f32x4*)(src + (size_t)mr * D_MODEL) + lane;
#pragma unroll
        for (int j = 0; j < 4; ++j) v[i][j] = __builtin_nontemporal_load(&xr[64 * j]); }
    for (int m = m0; m < m1; m += NB * step) {
#pragma unroll
        for (int i = 0; i < NB; ++i) { const int mn = m + (NB + i) * step, mr = mn < mlast ? mn : mlast; const GAS f32x4* xr = (const GAS f32x4*)(src + (size_t)mr * D_MODEL) + lane;
#pragma unroll
            for (int j = 0; j < 4; ++j) nx[i][j] = __builtin_nontemporal_load(&xr[64 * j]); }
#pragma unroll
        for (int i = 0; i < NB; ++i) {
            const int mi = m + i * step;
            float s = 0.f;
#pragma unroll
            for (int j = 0; j < 4; ++j) s += (v[i][j].x * v[i][j].x + v[i][j].y * v[i][j].y) + (v[i][j].z * v[i][j].z + v[i][j].w * v[i][j].w);
            const float r = rsqrtf(wave_sum(s) * (1.f / D_MODEL) + EPS);
            if (mi < m1) {
                GAS v2u* o8 = (GAS v2u*)(dst + (size_t)mi * D_MODEL) + lane;
#pragma unroll
                for (int j = 0; j < 4; ++j) { v2u w; w.x = pk2(v[i][j].x * r * gg[j].x, v[i][j].y * r * gg[j].y); w.y = pk2(v[i][j].z * r * gg[j].z, v[i][j].w * r * gg[j].w); o8[64 * j] = w; }
            }
        }
#pragma unroll
        for (int i = 0; i < NB; ++i)
#pragma unroll
            for (int j = 0; j < 4; ++j) v[i][j] = nx[i][j];
    }
}

struct EpiProj {
    static constexpr bool PERM = true, F16 = false;
    bf16_t* PROJ; bf16_t* MKV; int pm_base, mem_pm0, mem_b0;
    template <int ACT, bool H> __device__ __forceinline__ void tile(const pg8::f32x4 (&acc)[2][2][4][2], bf16_t* b0, bf16_t* b1, int pitch) const {
#pragma unroll
        for (int ai = 0; ai < 2; ++ai)
#pragma unroll
            for (int m = 0; m < 4; ++m) { const size_t ro = (size_t)(ai * 128 + m * 16) * pitch;
#pragma unroll
                for (int bj = 0; bj < 2; ++bj) { f32x2 p[4];
#pragma unroll
                    for (int e = 0; e < 2; ++e) { p[e] = (f32x2){acc[ai][bj][m][0][2 * e], acc[ai][bj][m][0][2 * e + 1]}; p[2 + e] = (f32x2){acc[ai][bj][m][1][2 * e], acc[ai][bj][m][1][2 * e + 1]}; }
#pragma unroll
                    for (int e = 0; e < 4; ++e) { if (ACT == 1) p[e] = gelu_tanh_pk(p[e]); else if (ACT == 2) p[e] = p[e] * QSCALE; else if (ACT == 3) p[e] = silu_pk(p[e]); }
                    pg8::u32x4 w;
                    if constexpr (H) { w.x = pg8::cvt_pk_f16(p[0].x, p[0].y); w.y = pg8::cvt_pk_f16(p[1].x, p[1].y); w.z = pg8::cvt_pk_f16(p[2].x, p[2].y); w.w = pg8::cvt_pk_f16(p[3].x, p[3].y); }
                    else { w.x = pg8::cvt_pk_bf16(p[0].x, p[0].y); w.y = pg8::cvt_pk_bf16(p[1].x, p[1].y); w.z = pg8::cvt_pk_bf16(p[2].x, p[2].y); w.w = pg8::cvt_pk_bf16(p[3].x, p[3].y); }
                    *(pg8::u32x4*)((bj ? b1 : b0) + ro) = w; } }
    }
    __device__ __forceinline__ void operator()(const pg8::f32x4 (&acc)[2][2][4][2], const pg8::Unit& u, int wr, int wc, int fr, int fq) const {
        const int c128 = wc * 32 + 8 * fq, c64 = (wc & 1) * 32 + 8 * fq, k64 = wc >> 1;
        if (u.pn < 11) {
            const size_t row = (size_t)(pm_base + u.pm) * 256 + wr * 64 + fr;
            if (u.pn < 4) {
                bf16_t* base = PROJ + (u.pn < 2 ? PU_OFF : PV_OFF) + (size_t)(2 * (u.pn & 1)) * MT * 128 + row * 128 + c128;
                if (u.pn < 2) tile<1, true>(acc, base, base + MT * 128, 128); else tile<1, false>(acc, base, base + MT * 128, 128);
            } else if (u.pn == 4 || u.pn == 6) {
                bf16_t* base = PROJ + (u.pn == 4 ? PQ_OFF : PMQ_OFF) + (size_t)k64 * MT * 64 + row * 64 + c64;
                tile<2, false>(acc, base, base + 2 * MT * 64, 64);
            } else if (u.pn == 5) {
                bf16_t* base = PROJ + PK_OFF + (size_t)k64 * MT * 64 + row * 64 + c64;
                tile<0, false>(acc, base, base + (PVV_OFF - PK_OFF), 64);
            } else {
                bf16_t* base = PROJ + PZ_OFF + (size_t)(4 * (u.pn - 7) + k64) * MT * 64 + row * 64 + c64;
                tile<3, true>(acc, base, base + 2 * MT * 64, 64);
            }
        } else {
            const int b = mem_b0 + (u.pm - mem_pm0); const size_t key = (size_t)wr * 64 + fr;
            bf16_t* base = MKV + (u.pn - 11) * MV_OFF + ((size_t)(b * 4 + k64) * MEM_LEN + key) * 64 + c64;
            tile<0, false>(acc, base, base + (size_t)2 * MEM_LEN * 64, 64);
        }
    }
};
struct EpiOut {
    static constexpr bool PERM = true, F16 = true;
    bf16_t* O; float* SSP; int pm_base;
    __device__ __forceinline__ void operator()(const pg8::f32x4 (&acc)[2][2][4][2], const pg8::Unit& u, int wr, int wc, int fr, int fq) const {
        const int row0 = (pm_base + u.pm) * 256 + wr * 64 + fr, col0 = u.pn * 256 + wc * 32 + 8 * fq;
#pragma unroll
        for (int ai = 0; ai < 2; ++ai)
#pragma unroll
            for (int m = 0; m < 4; ++m) { const int row = row0 + ai * 128 + m * 16; bf16_t* rowp = O + (size_t)row * D_MODEL + col0; float ss = 0.f;
#pragma unroll
                for (int bj = 0; bj < 2; ++bj) { const pg8::f32x4 v0 = acc[ai][bj][m][0], v1 = acc[ai][bj][m][1];
                    ss += (v0[0] * v0[0] + v0[1] * v0[1]) + (v0[2] * v0[2] + v0[3] * v0[3]) + (v1[0] * v1[0] + v1[1] * v1[1]) + (v1[2] * v1[2] + v1[3] * v1[3]);
                    pg8::u32x4 w; w.x = pg8::cvt_pk_bf16(v0[0], v0[1]); w.y = pg8::cvt_pk_bf16(v0[2], v0[3]); w.z = pg8::cvt_pk_bf16(v1[0], v1[1]); w.w = pg8::cvt_pk_bf16(v1[2], v1[3]);
                    *(pg8::u32x4*)(rowp + bj * 128) = w; }
                ss += __shfl_xor(ss, 16); ss += __shfl_xor(ss, 32);
                if (fq == 0) SSP[(size_t)row * 16 + u.pn * 4 + wc] = ss; }
    }
};

__device__ __forceinline__ int t5_bucket(int n) {
    if (n < 16) return n;
    int l = 16 + (int)(__logf((float)n * (1.f / 16.f)) * (16.f / 2.0794415416798357f));
    return l < 31 ? l : 31;
}

namespace mix {
typedef short bf16x8 __attribute__((ext_vector_type(8)));
typedef short s16x4 __attribute__((ext_vector_type(4)));
typedef float f32x16 __attribute__((ext_vector_type(16)));
typedef unsigned u32x4 __attribute__((ext_vector_type(4))); typedef unsigned u32x2 __attribute__((ext_vector_type(2)));
typedef float f32x2_t __attribute__((ext_vector_type(2))); typedef __bf16 bf16x2_t __attribute__((ext_vector_type(2)));
constexpr int L1_OFF = 33280, STG_OFF = 66560, STG_WAVE = 8192, BIAS_OFF = 132096  , WSF_OFF = 136192, BSP_OFF = 138752  , VGB_OFF = 140800  ;
constexpr int SWA_VSTR = 256 * 64 + 64;
constexpr int X_KH = 16384, X_VH = 16512, X_VSTR = 128 * 64 + 64;
constexpr int G_GRP = 16640, G_CSTR = 64 * 64 + 64;

__device__ __forceinline__ int crow(int r, int hi) { return (r & 3) + 8 * (r >> 2) + 4 * hi; }
__device__ __forceinline__ s16x4 vtr(const LAS unsigned char* p) { return __builtin_bit_cast(s16x4, __builtin_amdgcn_ds_read_tr16_b64_v4i16((LAS s16x4*)p)); }
__device__ __forceinline__ unsigned cvtpk(float lo, float hi) { f32x2_t v = {lo, hi}; bf16x2_t b = __builtin_convertvector(v, bf16x2_t); return __builtin_bit_cast(unsigned, b); }
typedef _Float16 h16x2 __attribute__((ext_vector_type(2)));
__device__ __forceinline__ unsigned cvtpk_h(float lo, float hi) { unsigned r; asm("v_cvt_pk_f16_f32 %0, %1, %2" : "=v"(r) : "v"(lo), "v"(hi)); return r; }
__device__ __forceinline__ unsigned hmul2(unsigned a, unsigned b) { return __builtin_bit_cast(unsigned, __builtin_bit_cast(h16x2, a) * __builtin_bit_cast(h16x2, b)); }
__device__ __forceinline__ u32x4 mul8(u32x4 a, u32x4 b) { u32x4 r;
#pragma unroll
    for (int e = 0; e < 4; ++e) r[e] = hmul2(a[e], b[e]);
    return r; }
__device__ __forceinline__ u32x4 mul8x3(u32x4 a, u32x4 b, u32x4 c) { u32x4 r;
#pragma unroll
    for (int e = 0; e < 4; ++e) r[e] = hmul2(hmul2(a[e], b[e]), c[e]);
    return r; }

__device__ __forceinline__ f32x16 qk_block(const LAS unsigned char* Kt, int key0, const bf16x8 (&qf)[4], int r32, int hi, f32x16 s) {
    const int key = key0 + r32, sw = (key >> 1) & 7; const LAS unsigned char* kr = Kt + key * 128;
#pragma unroll
    for (int d0 = 0; d0 < 4; ++d0) { const bf16x8 kf = *(const LAS bf16x8*)(kr + (((2 * d0 + hi) ^ sw) << 4)); s = __builtin_amdgcn_mfma_f32_32x32x16_bf16(kf, qf[d0], s, 0, 0, 0); }
    return s;
}
__device__ __forceinline__ void pv_block(f32x16 (&o)[2], const f32x16& p, const LAS unsigned char* Vt, int vstr, int key0, int lane) {
    const LAS unsigned char* vb = Vt + (key0 + 4 * (lane >> 5) + ((lane >> 2) & 3)) * 64 + ((lane >> 4) & 1) * 32 + (lane & 3) * 8;
#pragma unroll
    for (int s = 0; s < 2; ++s) {
        u32x4 pw; pw[0] = cvtpk(p[8 * s + 0], p[8 * s + 1]); pw[1] = cvtpk(p[8 * s + 2], p[8 * s + 3]); pw[2] = cvtpk(p[8 * s + 4], p[8 * s + 5]); pw[3] = cvtpk(p[8 * s + 6], p[8 * s + 7]);
        const bf16x8 pa = __builtin_bit_cast(bf16x8, pw);
#pragma unroll
        for (int dblk = 0; dblk < 2; ++dblk) {
            const s16x4 lo = vtr(vb + dblk * vstr + s * 1024), hi4 = vtr(vb + dblk * vstr + s * 1024 + 512);
            const bf16x8 vf = {lo[0], lo[1], lo[2], lo[3], hi4[0], hi4[1], hi4[2], hi4[3]};
            o[dblk] = __builtin_amdgcn_mfma_f32_32x32x16_bf16(vf, pa, o[dblk], 0, 0, 0);
        }
    }
}
struct TileSrc { const bf16_t* p; long s_hi; };
__device__ __forceinline__ void load_half(u32x4 (&r)[4], const TileSrc t, int tid) {
    const bf16_t* p = t.p + (long)tid * 8;
#pragma unroll
    for (int it = 0; it < 4; ++it) r[it] = *(const u32x4*)(p + (it >> 1) * t.s_hi + (it & 1) * 4096);
}
__device__ __forceinline__ void write_k(const u32x4 (&r)[4], LAS unsigned char* L, bool zero_lo, int tid) {
    const int ch = tid & 7, kl = tid >> 3; LAS unsigned char* d = L + kl * 128 + ((ch ^ ((kl >> 1) & 7)) << 4);
    const unsigned keep = zero_lo ? 0u : 0xffffffffu;
#pragma unroll
    for (int it = 0; it < 4; ++it) { u32x4 v = r[it]; if (it < 2) { v[0] &= keep; v[1] &= keep; v[2] &= keep; v[3] &= keep; } *(LAS u32x4*)(d + it * 8192) = v; }
}
__device__ __forceinline__ void write_v_swa(const u32x4 (&r)[4], LAS unsigned char* L, bool zero_lo, int tid) {
    const int ch = tid & 7, kl = tid >> 3; LAS unsigned char* d = L + (ch >> 2) * SWA_VSTR + kl * 64 + (ch & 3) * 16;
    const unsigned keep = zero_lo ? 0u : 0xffffffffu;
#pragma unroll
    for (int it = 0; it < 4; ++it) { u32x4 v = r[it]; if (it < 2) { v[0] &= keep; v[1] &= keep; v[2] &= keep; v[3] &= keep; } *(LAS u32x4*)(d + it * 4096) = v; }
}
__device__ __forceinline__ void write_v_x(const u32x4 (&r)[4], LAS unsigned char* L, int tid) {
    const int ch = tid & 7, kl = tid >> 3; LAS unsigned char* d = L + (ch >> 2) * X_VSTR + kl * 64 + (ch & 3) * 16;
#pragma unroll
    for (int it = 0; it < 4; ++it) *(LAS u32x4*)(d + (it >> 1) * X_VH + (it & 1) * 4096) = r[it];
}
template <int CTRL> __device__ __forceinline__ float dpp_f(float v) { return __builtin_bit_cast(float, __builtin_amdgcn_update_dpp(0, __builtin_bit_cast(int, v), CTRL, 0xf, 0xf, false)); }
__device__ __forceinline__ float row16_sum(float v) {
    v += dpp_f<0xB1>(v); v += dpp_f<0x4E>(v); v += dpp_f<0x141>(v); v += dpp_f<0x140>(v);
    return v;
}
__device__ __forceinline__ void write_g(const u32x4 (&r)[4], LAS unsigned char* L, const LAS float* vgb, int gp, int tid) {
    const int ch = tid & 15;
#pragma unroll
    for (int it = 0; it < 4; ++it) { const int gl = it >> 1, srow = (it & 1) * 32 + (tid >> 4), g = 2 * gp + gl;
        float v[8];
#pragma unroll
        for (int e = 0; e < 4; ++e) { v[2 * e] = bflo(r[it][e]); v[2 * e + 1] = bfhi(r[it][e]); }
        const float mu = row16_sum(((v[0] + v[1]) + (v[2] + v[3])) + ((v[4] + v[5]) + (v[6] + v[7]))) * (1.f / 128.f); float sq = 0.f;
#pragma unroll
        for (int e = 0; e < 8; ++e) { v[e] -= mu; sq += v[e] * v[e]; }
        const float rs = rsqrtf(row16_sum(sq) * (1.f / 128.f) + EPS);
        const LAS f32x4* gq = (const LAS f32x4*)(vgb + g * 128 + ch * 8); const LAS f32x4* bq = (const LAS f32x4*)(vgb + 512 + g * 128 + ch * 8);
        const f32x4 g0 = gq[0], g1 = gq[1], b0 = bq[0], b1 = bq[1];
        u32x4 w;
        w[0] = cvtpk(v[0] * rs * g0[0] + b0[0], v[1] * rs * g0[1] + b0[1]); w[1] = cvtpk(v[2] * rs * g0[2] + b0[2], v[3] * rs * g0[3] + b0[3]);
        w[2] = cvtpk(v[4] * rs * g1[0] + b1[0], v[5] * rs * g1[1] + b1[1]); w[3] = cvtpk(v[6] * rs * g1[2] + b1[2], v[7] * rs * g1[3] + b1[3]);
        *(LAS u32x4*)(L + gl * G_GRP + (ch >> 2) * G_CSTR + srow * 64 + (ch & 3) * 16) = w; }
}
__device__ __forceinline__ void attn_out(const f32x16 (&o)[2], float rinv, LAS unsigned char* stg, const u32x4 (&zv)[4], bf16_t* yrow0, int lane) {
    const int r32 = lane & 31, hi = lane >> 5;
    LAS unsigned char* wr = stg + r32 * 128 + hi * 8; const int sw = (r32 >> 1) & 7;
#pragma unroll
    for (int dblk = 0; dblk < 2; ++dblk)
#pragma unroll
        for (int rq = 0; rq < 4; ++rq) { u32x2 w; w[0] = cvtpk_h(o[dblk][4 * rq] * rinv, o[dblk][4 * rq + 1] * rinv); w[1] = cvtpk_h(o[dblk][4 * rq + 2] * rinv, o[dblk][4 * rq + 3] * rinv);
            *(LAS u32x2*)(wr + (((dblk * 4 + rq) ^ sw) << 4)) = w; }
    LDS_WAIT();
#pragma unroll
    for (int i = 0; i < 4; ++i) { const int row = i * 8 + (lane >> 3), ch = lane & 7;
        const u32x4 v = *(const LAS u32x4*)(stg + row * 128 + ((ch ^ ((row >> 1) & 7)) << 4));
        *(u32x4*)(yrow0 + (size_t)row * D_MODEL + ch * 8) = mul8(v, zv[i]); }
    LDS_WAIT();
}
__device__ __forceinline__ void load_z4(u32x4 (&zv)[4], const bf16_t* zrow0, int lane) {
#pragma unroll
    for (int i = 0; i < 4; ++i) zv[i] = __builtin_nontemporal_load((const u32x4*)(zrow0 + (size_t)(i * 8 + (lane >> 3)) * 64 + (lane & 7) * 8));
}
__device__ __forceinline__ void load_q4(bf16x8 (&q)[4], const bf16_t* qp) {
#pragma unroll
    for (int d0 = 0; d0 < 4; ++d0) q[d0] = *(const bf16x8*)(qp + 16 * d0);
}

__device__ __forceinline__ void mix_unit(int unit, LAS unsigned char* lds, const bf16_t* __restrict__ PROJ, const bf16_t* __restrict__ MKV, const bf16_t* __restrict__ WSP, bf16_t* __restrict__ Y, int tid, int wave) {
    const int b = unit >> 4, n = unit & 15, rb = wave & 3, wh = wave >> 2;
    const size_t row0 = (size_t)b * SEQ + (size_t)n * CHUNK;
    const size_t wrow0 = row0 + 32 * rb;
    LAS unsigned char* const L0 = lds; LAS unsigned char* const L1 = lds + L1_OFF;
    LAS unsigned char* stg = lds + STG_OFF + wave * STG_WAVE;
    const LAS float* btab = (const LAS float*)(lds + BIAS_OFF);
    const LAS float* bstab = (const LAS float*)(lds + BSP_OFF);
    const LAS float* vgb = (const LAS float*)(lds + VGB_OFF);
    const int tid_in = tid;
    const bool first = (n == 0);
#define MIX_BAR() asm volatile("s_waitcnt lgkmcnt(0)\n\ts_barrier" ::: "memory")
#define MIX_LANES() int tid = tid_in; asm volatile("" : "+v"(tid)); const int lane = tid & 63, r32 = lane & 31, hi = lane >> 5; const size_t qoff = (wrow0 + r32) * 64 + 8 * hi;
    auto tile_src = [&](int j) -> TileSrc {
        TileSrc t; j = j > 15 ? 15 : j;
        if (j < 4) { t.p = PROJ + ((j & 1) ? PVV_OFF : PK_OFF) + (size_t)(j >> 1) * MT * 64 + ((long)row0 - 128) * 64; t.s_hi = 8192; }
        else if (j < 12) { const int x = j - 4, st = x >> 1; t.p = MKV + ((x & 1) ? MV_OFF : 0) + ((size_t)(b * 4 + 2 * (st >> 1)) * MEM_LEN + (st & 1) * 128) * 64; t.s_hi = (long)MEM_LEN * 64; }
        else { const int y = j - 12; t.p = PROJ + PV_OFF + (size_t)(2 * (y >> 1)) * MT * 128 + (row0 + (y & 1) * 64) * 128; t.s_hi = (long)MT * 128; }
        return t; };
    u32x4 R0[4], R1[4]; bf16x8 qf[4];
    { MIX_LANES();
      load_half(R0, tile_src(0), tid); load_q4(qf, PROJ + PQ_OFF + (size_t)wh * MT * 64 + qoff);
      MIX_BAR();
      write_k(R0, L0, first, tid);
      load_half(R1, tile_src(1), tid); load_half(R0, tile_src(2), tid); }

#pragma unroll 1
    for (int kvh = 0; kvh < 2; ++kvh) {
        const int h = 2 * kvh + wh, j = 2 * kvh;
        f32x16 s[5]; float rinv; u32x4 zv[4];
        { MIX_LANES(); (void)qoff;
          MIX_BAR();
          write_v_swa(R1, L1, first, tid);
          load_z4(zv, PROJ + PZ_OFF + (size_t)(8 + h) * MT * 64 + wrow0 * 64, lane);
          load_half(R1, tile_src(j + 3), tid);
#pragma unroll
          for (int t = 0; t < 5; ++t) {
              const LAS float* tb = btab + ((first && rb + t < 4) ? 4 : h) * 192 + (31 - r32 + 4 * hi);
#pragma unroll
              for (int r = 0; r < 16; ++r) s[t][r] = tb[32 * t + (r & 3) + 8 * (r >> 2)];
          }
#pragma unroll
          for (int t = 0; t < 5; ++t) s[t] = qk_block(L0, 32 * (rb + t), qf, r32, hi, s[t]);
          const float sink2 = btab[5 * 192 + h]; float m = sink2;
#pragma unroll
          for (int t = 0; t < 5; ++t)
#pragma unroll
              for (int r = 0; r < 16; ++r) m = fmaxf(m, s[t][r]);
          m = fmaxf(m, __shfl_xor(m, 32));
          float l = 0.f;
#pragma unroll
          for (int t = 0; t < 5; ++t)
#pragma unroll
              for (int r = 0; r < 16; ++r) { const float p = __builtin_amdgcn_exp2f(s[t][r] - m); s[t][r] = p; l += p; }
          l += __shfl_xor(l, 32);
          rinv = __builtin_amdgcn_rcpf(l + __builtin_amdgcn_exp2f(sink2 - m)); }
        { MIX_LANES();
          MIX_BAR();
          write_k(R0, L0, kvh == 0 && first, tid);
          load_q4(qf, PROJ + (kvh == 0 ? PQ_OFF + (size_t)(2 + wh) * MT * 64 : PMQ_OFF + (size_t)wh * MT * 64) + qoff);
          load_half(R0, tile_src(j + 4), tid);
          f32x16 o[2] = {};
#pragma unroll
          for (int t = 0; t < 5; ++t) pv_block(o, s[t], L1, SWA_VSTR, 32 * (rb + t), lane);
          attn_out(o, rinv, stg, zv, Y + wrow0 * D_MODEL + 512 + h * 64, lane); }
    }
    {
        float m = -INFINITY, l = 0.f; f32x16 o[2] = {};
#pragma unroll 1
        for (int st = 0; st < 4; ++st) {
            const int hp = st >> 1, half = st & 1, h = 2 * hp + wh, j = 4 + 2 * st;
            f32x16 s[4]; float f; u32x4 zv[4];
            { MIX_LANES(); (void)qoff;
              if (half == 0) { m = -INFINITY; l = 0.f; o[0] = (f32x16){}; o[1] = (f32x16){}; }
              MIX_BAR();
              write_v_x(R1, L1, tid);
              load_z4(zv, PROJ + PZ_OFF + (size_t)(12 + h) * MT * 64 + wrow0 * 64, lane);
              load_half(R1, tile_src(j + 3), tid);
              const LAS unsigned char* Kt = L0 + wh * X_KH;
#pragma unroll
              for (int t = 0; t < 4; ++t) s[t] = qk_block(Kt, 32 * t, qf, r32, hi, (f32x16){});
              float mloc = -INFINITY;
#pragma unroll
              for (int t = 0; t < 4; ++t)
#pragma unroll
                  for (int r = 0; r < 16; ++r) mloc = fmaxf(mloc, s[t][r]);
              mloc = fmaxf(mloc, __shfl_xor(mloc, 32));
              const float mn = fmaxf(m, mloc); f = __builtin_amdgcn_exp2f(m - mn);
              float ls = 0.f;
#pragma unroll
              for (int t = 0; t < 4; ++t)
#pragma unroll
                  for (int r = 0; r < 16; ++r) { const float p = __builtin_amdgcn_exp2f(s[t][r] - mn); s[t][r] = p; ls += p; }
              ls += __shfl_xor(ls, 32);
              l = l * f + ls; m = mn; }
            { MIX_LANES();
              MIX_BAR();
              if (st < 3) write_k(R0, L0, false, tid); else write_g(R0, L0, vgb, 0, tid);
              load_q4(qf, PROJ + PMQ_OFF + (size_t)(2 * (st < 3 ? ((st + 1) >> 1) : hp) + wh) * MT * 64 + qoff);
              load_half(R0, tile_src(j + 4), tid);
              if (half == 1) { o[0] *= f; o[1] *= f; }
              const LAS unsigned char* Vt = L1 + wh * X_VH;
#pragma unroll
              for (int t = 0; t < 4; ++t) pv_block(o, s[t], Vt, X_VSTR, 32 * t, lane);
              if (half == 1) attn_out(o, __builtin_amdgcn_rcpf(l), stg, zv, Y + wrow0 * D_MODEL + 768 + h * 64, lane); }
        }
    }
#pragma unroll 1
    for (int gp = 0; gp < 2; ++gp) {
        const int g = 2 * gp + wh, nks = 2 * rb + 2, j = 12 + 2 * gp;
        f32x16 acc[4] = {}; u32x4 uv[8], zv[8]; bf16x8 af[8];
        { MIX_LANES(); (void)qoff;
          const bf16_t* wrow = WSP + ((size_t)(g * 128 + 32 * rb + r32)) * 128 + 8 * hi;
#pragma unroll
          for (int ks = 0; ks < 8; ++ks) af[ks] = *(const bf16x8*)(wrow + 16 * ks);
          MIX_BAR();
          write_g(R1, L1, vgb, gp, tid);
#pragma unroll
          for (int i = 0; i < 8; ++i) { const size_t row = wrow0 + i * 4 + (lane >> 4); const int ch = lane & 15;
              uv[i] = __builtin_nontemporal_load((const u32x4*)(PROJ + PU_OFF + (size_t)g * MT * 128 + row * 128 + ch * 8));
              zv[i] = __builtin_nontemporal_load((const u32x4*)(PROJ + PZ_OFF + (size_t)(2 * g + (ch >> 3)) * MT * 64 + row * 64 + (ch & 7) * 8)); }
          load_half(R1, tile_src(j + 3), tid);
          const LAS unsigned char* tb = L0 + wh * G_GRP + (8 * hi + ((lane >> 2) & 3)) * 64 + ((lane >> 4) & 1) * 32 + (lane & 3) * 8;
#pragma unroll
          for (int ks = 0; ks < 4; ++ks) if (ks < nks) {
#pragma unroll
              for (int cb = 0; cb < 4; ++cb) {
                  const s16x4 lo = vtr(tb + cb * G_CSTR + ks * 1024), hi4 = vtr(tb + cb * G_CSTR + ks * 1024 + 256);
                  const bf16x8 bfv = {lo[0], lo[1], lo[2], lo[3], hi4[0], hi4[1], hi4[2], hi4[3]};
                  acc[cb] = __builtin_amdgcn_mfma_f32_32x32x16_bf16(bfv, af[ks], acc[cb], 0, 0, 0);
              }
          } }
        { MIX_LANES(); (void)qoff;
          MIX_BAR();
          if (gp == 0) write_g(R0, L0, vgb, 1, tid);
          load_half(R0, tile_src(j + 4), tid);
          const LAS unsigned char* tb = L1 + wh * G_GRP + (8 * hi + ((lane >> 2) & 3)) * 64 + ((lane >> 4) & 1) * 32 + (lane & 3) * 8;
#pragma unroll
          for (int ks = 4; ks < 8; ++ks) if (ks < nks) {
#pragma unroll
              for (int cb = 0; cb < 4; ++cb) {
                  const s16x4 lo = vtr(tb + cb * G_CSTR + (ks - 4) * 1024), hi4 = vtr(tb + cb * G_CSTR + (ks - 4) * 1024 + 256);
                  const bf16x8 bfv = {lo[0], lo[1], lo[2], lo[3], hi4[0], hi4[1], hi4[2], hi4[3]};
                  acc[cb] = __builtin_amdgcn_mfma_f32_32x32x16_bf16(bfv, af[ks], acc[cb], 0, 0, 0);
              }
          }
          const float bs = bstab[g * 128 + 32 * rb + r32];
          LAS unsigned char* wr = stg + r32 * 256 + hi * 8; const int sw = r32 & 15;
#pragma unroll
          for (int cb = 0; cb < 4; ++cb)
#pragma unroll
              for (int rq = 0; rq < 4; ++rq) { u32x2 w; w[0] = cvtpk_h(acc[cb][4 * rq] + bs, acc[cb][4 * rq + 1] + bs); w[1] = cvtpk_h(acc[cb][4 * rq + 2] + bs, acc[cb][4 * rq + 3] + bs);
                  *(LAS u32x2*)(wr + (((cb * 4 + rq) ^ sw) << 4)) = w; }
          LDS_WAIT();
#pragma unroll
          for (int i = 0; i < 8; ++i) { const int row = i * 4 + (lane >> 4), ch = lane & 15;
              const u32x4 sv = *(const LAS u32x4*)(stg + row * 256 + ((ch ^ (row & 15)) << 4));
              *(u32x4*)(Y + (wrow0 + row) * D_MODEL + g * 128 + ch * 8) = mul8x3(sv, uv[i], zv[i]); }
          LDS_WAIT(); }
    }
    { MIX_BAR(); }
#undef MIX_LANES
#undef MIX_BAR
}
}

__global__ void __launch_bounds__(NWAVES * 64, 2) hymba_fwd(Args args) {
    extern __shared__ __attribute__((aligned(16))) unsigned char lds_raw[];
    LAS unsigned char* lds = (LAS unsigned char*)lds_raw;
    volatile LAS unsigned* MISC = (volatile LAS unsigned*)(lds + MISC_OFF);
    const int tid = threadIdx.x, lane = tid & 63, wave = __builtin_amdgcn_readfirstlane(tid >> 6);
    const int G = gridDim.x; const int bx = blockIdx.x; const int vcu = (G % 8 == 0) ? (bx % 8) * (G / 8) + bx / 8 : bx;
    unsigned char* ws = args.ws;
    unsigned* ctl = (unsigned*)(ws + WS_CTL);
    bf16_t* WIN_T = (bf16_t*)(ws + WS_WIN); bf16_t* WOUT_T = (bf16_t*)(ws + WS_WOUT); bf16_t* WSP = (bf16_t*)(ws + WS_WSP); float* SSP = (float*)(ws + WS_SSP);
    bf16_t* XN = (bf16_t*)(ws + WS_XN); bf16_t* PROJ = (bf16_t*)(ws + WS_PROJ); bf16_t* MKV = (bf16_t*)(ws + WS_MKV); bf16_t* Y = (bf16_t*)(ws + WS_Y); bf16_t* O = (bf16_t*)(ws + WS_O);
    for (int u = tid; u < (LDS_BYTES - LDSCTL_OFF) / 4; u += NWAVES * 64) ((LAS unsigned*)(lds + LDSCTL_OFF))[u] = 0u;
    __syncthreads();
    const int NG = (G == 256) ? 2 : 1, Gg = G / NG, grp = bx / Gg, cg = bx - grp * Gg;
    const int vcug = (Gg % 8 == 0) ? (cg % 8) * (Gg / 8) + cg / 8 : cg;
    const int MH = M_TOK / NG, MMH = M_MEM / NG, row_base = grp * MH, pm_base = row_base / 256;
    XcdBarrier barG = xcd_barrier_post(ctl + CW_BAR, MISC + 8, (unsigned)G);
    XcdBarrier barH = barG;
    if (NG == 2) barH = xcd_barrier_post(ctl + CW_BAR + (1 + grp) * XCD_BAR_WORDS, MISC + 10, (unsigned)Gg);
    const int gw = vcu * NWAVES + wave, NGW = G * NWAVES, gwg = vcug * NWAVES + wave, NGWg = Gg * NWAVES;

    {
        rms_rows_to_bf16<4>(args.x, args.g_pre, XN, gw, MH, NGW, lane);
        rms_rows_to_bf16<2>(args.mem, args.g_mem, XN + (size_t)M_TOK * D_MODEL, gw, M_MEM, NGW, lane);
        LAS float* scr = (LAS float*)(lds + wave * 16384);
        constexpr int I_IN = (D_MODEL / 64) * (IN_WIDTH / 32), I_MKV = (D_MODEL / 64) * (MKV_W / 32), I_OUT = (D_MODEL / 64) * (D_MODEL / 32);
        for (int it = NGW - 1 - gw; it < I_IN + I_MKV + I_OUT; it += NGW) {
            int r = it;
            if (r < I_IN) { p0_transpose_item<false>(args.w_in, D_MODEL, IN_WIDTH, WIN_T, 0, scr, r, lane); continue; } r -= I_IN;
            if (r < I_MKV) { p0_transpose_item<false>(args.w_mkv, D_MODEL, MKV_W, WIN_T, IN_WIDTH, scr, r, lane); continue; } r -= I_MKV;
            p0_transpose_item<true>(args.w_out, D_MODEL, D_MODEL, WOUT_T, 0, scr, r, lane);
        }
        for (int e = bx * 512 + tid; e < 4 * 128 * 128; e += G * 512) { const int s = e & 127, t = (e >> 7) & 127; WSP[e] = (bf16_t)f2bf(s <= t ? args.wsp[e] : 0.f); }
        xcd_barrier(barG);
    }
    if (grp == 1) {
        rms_rows_to_bf16<4>(args.x + (size_t)row_base * D_MODEL, args.g_pre, XN + (size_t)row_base * D_MODEL, gwg, MH, NGWg, lane);
        xcd_barrier(barH);
    }
    {
        pg8::Gemm g{XN + (size_t)row_base * D_MODEL, WIN_T, MH, IN_WIDTH + MKV_W, D_MODEL};
        pg8::MergedOrder S; S.S.init(MH, IN_WIDTH, Gg, cg, NG == 2 ? 4 : 8); S.eM = MMH / 256; S.eN = MKV_W / 256; S.ePm0 = (M_TOK + grp * MMH - row_base) / 256;
        EpiProj E{PROJ, MKV, pm_base, S.ePm0, grp * (BATCH / NG)};
        pg8::gemm_phase<EpiProj, pg8::MergedOrder, true, true>(lds, g, S, E);
        xcd_barrier(barH);
    }
    {
        for (int idx = tid; idx < 5 * 192; idx += NWAVES * 64) { const int h = idx / 192, dist = 159 - (idx % 192);
            ((LAS float*)(lds + mix::BIAS_OFF))[idx] = (h < 4 && dist >= 0 && dist < 128) ? args.relb[t5_bucket(dist) * 4 + h] * LOG2E : -INFINITY; }
        if (tid < 4) ((LAS float*)(lds + mix::BIAS_OFF))[5 * 192 + tid] = args.sinks[tid] * LOG2E;
        ((LAS float*)(lds + mix::BSP_OFF))[tid] = args.bsp[tid];
        ((LAS float*)(lds + mix::VGB_OFF))[tid] = args.vg[tid]; ((LAS float*)(lds + mix::VGB_OFF))[512 + tid] = args.vb[tid];
        __syncthreads();
        const int nu = BATCH * (SEQ / CHUNK) / NG;
        for (int u = vcug; u < nu; u += Gg) mix::mix_unit(grp * nu + u, lds, PROJ, MKV, WSP, Y, tid, wave);
        xcd_barrier(barH);
    }
    {
        pg8::Gemm g{Y + (size_t)row_base * D_MODEL, WOUT_T, MH, D_MODEL, D_MODEL};
        pg8::StaticOrder S; S.init(MH, D_MODEL, Gg, cg, NG == 2 ? 4 : 8);
        EpiOut E{O, SSP, pm_base};
        pg8::gemm_phase<EpiOut, pg8::StaticOrder, true, true>(lds, g, S, E);
        xcd_barrier(barH);
    }
    {
        const GAS f32x4* gp = (const GAS f32x4*)args.g_post + lane;
        f32x4 gg[4];
#pragma unroll
        for (int j = 0; j < 4; ++j) gg[j] = gp[64 * j];
        constexpr int NB = 4;
        const int m_end = row_base + MH;
        for (int m0 = row_base + gwg; m0 < m_end; m0 += NB * NGWg) {
            v2u ov[NB][4]; f32x4 xv[NB][4]; float ssp[NB];
#pragma unroll
            for (int i = 0; i < NB; ++i) { const int m = (m0 + i * NGWg < m_end) ? m0 + i * NGWg : m0;
                const GAS v2u* orow = (const GAS v2u*)(O + (size_t)m * D_MODEL) + lane; const GAS f32x4* xr = (const GAS f32x4*)(args.x + (size_t)m * D_MODEL) + lane;
#pragma unroll
                for (int j = 0; j < 4; ++j) { ov[i][j] = __builtin_nontemporal_load(&orow[64 * j]); xv[i][j] = __builtin_nontemporal_load(&xr[64 * j]); }
                ssp[i] = SSP[(size_t)m * 16 + (lane & 15)]; }
#pragma unroll
            for (int i = 0; i < NB; ++i) { const int m = m0 + i * NGWg;
                const float r = rsqrtf(wave_sum(ssp[i]) * 0.25f * (1.f / D_MODEL) + EPS);
                if (m < m_end) {
                    GAS f32x4* outr = (GAS f32x4*)(args.out + (size_t)m * D_MODEL) + lane;
#pragma unroll
                    for (int j = 0; j < 4; ++j) { f32x4 o;
                        o.x = xv[i][j].x + bflo(ov[i][j].x) * r * gg[j].x; o.y = xv[i][j].y + bfhi(ov[i][j].x) * r * gg[j].y; o.z = xv[i][j].z + bflo(ov[i][j].y) * r * gg[j].z; o.w = xv[i][j].w + bfhi(ov[i][j].y) * r * gg[j].w;
                        __builtin_nontemporal_store(o, &outr[64 * j]); }
                }
            }
        }
    }
}

extern "C" void kernel_launch(void* const* d_in, const int* in_sizes, int n_in, void* d_out, int out_size, void* d_ws, size_t ws_size, hipStream_t stream) {
    static int grid = 0;
    if (grid == 0) {
        if (n_in != 14 || in_sizes[0] != M_TOK * D_MODEL || out_size != M_TOK * D_MODEL || ws_size < WS_END) { fprintf(stderr, "kernel_launch: unexpected shapes (n_in %d, ws %zu)\n", n_in, ws_size); grid = -1; return; }
        int dev = 0, cus = 0, per_cu = 0;
        if (hipGetDevice(&dev) != hipSuccess || hipDeviceGetAttribute(&cus, hipDeviceAttributeMultiprocessorCount, dev) != hipSuccess) { grid = -1; return; }
        if (hipFuncSetAttribute((const void*)hymba_fwd, hipFuncAttributeMaxDynamicSharedMemorySize, LDS_BYTES) != hipSuccess) { fprintf(stderr, "kernel_launch: hipFuncSetAttribute failed\n"); grid = -1; return; }
        if (hipOccupancyMaxActiveBlocksPerMultiprocessor(&per_cu, (const void*)hymba_fwd, NWAVES * 64, LDS_BYTES) != hipSuccess || per_cu < 1) { fprintf(stderr, "kernel_launch: occupancy query says %d blocks/CU\n", per_cu); per_cu = 1; }
        (void)hipGetLastError();
        grid = cus;
    }
    if (grid < 0) return;
    (void)hipMemsetAsync((char*)d_ws + WS_CTL, 0, CTL_ZERO_BYTES, stream);
    Args a{};
    a.x = (const float*)d_in[0]; a.mem = (const float*)d_in[1]; a.g_pre = (const float*)d_in[2]; a.g_post = (const float*)d_in[3]; a.g_mem = (const float*)d_in[4];
    a.w_in = (const float*)d_in[5]; a.w_mkv = (const float*)d_in[6]; a.vg = (const float*)d_in[7]; a.vb = (const float*)d_in[8]; a.wsp = (const float*)d_in[9]; a.bsp = (const float*)d_in[10];
    a.sinks = (const float*)d_in[11]; a.relb = (const float*)d_in[12]; a.w_out = (const float*)d_in[13];
    a.out = (float*)d_out; a.ws = (unsigned char*)d_ws;
    hipLaunchKernelGGL(hymba_fwd, dim3(grid), dim3(NWAVES * 64), LDS_BYTES, stream, a);
}
```
